# Optimizing an MI355X kernel written in HIP

```python
import math
import jax, jax.numpy as jnp
from jax import lax
import numpy as np

D_MODEL = 1024
BATCH = 32
SEQ = 2048
DEPTH = 1

D_MIX = D_MODEL
GLA_HEADS = 4
GLA_DV = (D_MIX // 2) // GLA_HEADS
GLA_DK = GLA_DV // 2
GLA_GATE_RANK = 16
GLA_TAU = 16.0
GLA_CHUNK = 64
MOBA_HEADS = 8
MOBA_HD = (D_MIX - GLA_HEADS * GLA_DV) // MOBA_HEADS
MOBA_BLOCK = 256
MOBA_TOPK = 3
MOBA_QCHUNK = 8
REL_BUCKETS = 32
REL_MAX_DIST = 128
D_FF = 4 * D_MODEL
N_ADA = 6
EPS = 1e-6

GLA_QK_W = GLA_HEADS * GLA_DK
GLA_V_W = GLA_HEADS * GLA_DV
MOBA_W = MOBA_HEADS * MOBA_HD
IN_WIDTHS = (GLA_QK_W, GLA_QK_W, GLA_V_W, GLA_V_W, GLA_GATE_RANK, MOBA_W, MOBA_W, MOBA_W)
D_IN = sum(IN_WIDTHS)
IN_SPLITS = [int(v) for v in np.cumsum(IN_WIDTHS)[:-1]]

kernel_name = "hybrid_gla_moba_adaln_block"


def rmsnorm(x, g):
    xf = x.astype(jnp.float32)
    y = xf * lax.rsqrt(jnp.mean(xf * xf, axis=-1, keepdims=True) + EPS)
    return y.astype(x.dtype) * g


def modulate(h, shift, scale):
    return h * (1.0 + scale[:, None, :]) + shift[:, None, :]


def gla_mixer(q, k, v, log_a):
    B, S, H, dk = q.shape
    dv = v.shape[-1]
    C = GLA_CHUNK
    N = S // C
    f32 = jnp.float32

    def chunks(t):
        return t.astype(f32).reshape(B, N, C, H, t.shape[-1]).transpose(0, 3, 1, 2, 4)

    q = chunks(q) * (dk ** -0.5)
    k = chunks(k)
    v = chunks(v)
    g = chunks(log_a)
    b = jnp.cumsum(g, axis=3)
    b_last = b[:, :, :, -1:, :]
    b_ref = b[:, :, :, C // 2 - 1:C // 2, :]
    att = jnp.einsum('bhnid,bhnjd->bhnij', q * jnp.exp(b - b_ref), k * jnp.exp(b_ref - b))
    causal = jnp.tril(jnp.ones((C, C), dtype=bool))
    att = jnp.where(causal, att, 0.0)
    o_intra = jnp.einsum('bhnij,bhnjv->bhniv', att, v)
    kv = jnp.einsum('bhncd,bhncv->bhndv', k * jnp.exp(b_last - b), v)
    decay = jnp.exp(b_last[:, :, :, 0, :])

    def step(s_prev, inp):
        kv_n, dec_n = inp
        return dec_n[..., None] * s_prev + kv_n, s_prev

    s0 = jnp.zeros((B, H, dk, dv), f32)
    _, s_before = lax.scan(step, s0, (kv.transpose(2, 0, 1, 3, 4), decay.transpose(2, 0, 1, 3)))
    s_before = s_before.transpose(1, 2, 0, 3, 4)
    o_inter = jnp.einsum('bhncd,bhndv->bhncv', q * jnp.exp(b), s_before)
    o = o_intra + o_inter
    return o.transpose(0, 2, 3, 1, 4).reshape(B, S, H, dv)


def t5_bucket(rel):
    n = jnp.maximum(rel, 0)
    max_exact = REL_BUCKETS // 2
    ratio = jnp.maximum(n, 1).astype(jnp.float32) / max_exact
    large = max_exact + (jnp.log(ratio) / math.log(REL_MAX_DIST / max_exact)
                         * (REL_BUCKETS - max_exact)).astype(jnp.int32)
    large = jnp.minimum(large, REL_BUCKETS - 1)
    return jnp.where(n < max_exact, n, large)


def moba_mixer(q, k, v, rel_bias):
    B, S, H, hd = q.shape
    BLK = MOBA_BLOCK
    QC = MOBA_QCHUNK
    NB = -(-S // BLK)
    Sp = NB * BLK
    topk = min(MOBA_TOPK, NB)
    f32 = jnp.float32
    qh = q.transpose(0, 2, 1, 3) * (hd ** -0.5)
    pad = ((0, 0), (0, 0), (0, Sp - S), (0, 0))
    kb = jnp.pad(k.transpose(0, 2, 1, 3), pad).reshape(B, H, NB, BLK, hd)
    vb = jnp.pad(v.transpose(0, 2, 1, 3), pad).reshape(B, H, NB, BLK, hd)
    k_mean = jnp.mean(kb.astype(f32), axis=3)
    bias_flat = rel_bias.T.reshape(-1)
    head_off = (jnp.arange(H, dtype=jnp.int32) * REL_BUCKETS)[None, :, None, None]
    blk_pos = jnp.arange(BLK, dtype=jnp.int32)
    blk_ids = jnp.arange(NB, dtype=jnp.int32)
    nq = S // QC
    q_chunks = qh.reshape(B, H, nq, QC, hd).transpose(2, 0, 1, 3, 4)
    gather_blocks = jax.vmap(jax.vmap(lambda kk, ii: kk[ii]))

    def one_chunk(args):
        ci, q_c = args
        t = ci * QC + jnp.arange(QC, dtype=jnp.int32)
        own = (ci * QC) // BLK
        gate = jnp.einsum('bhqd,bhnd->bhqn', q_c.astype(f32), k_mean)
        gate = jnp.where(blk_ids < own, gate, -jnp.inf)
        gval, gidx = lax.top_k(gate, topk)
        valid = jnp.isfinite(gval)
        k_sel = gather_blocks(kb, gidx)
        v_sel = gather_blocks(vb, gidx)
        s_sel = jnp.einsum('bhqd,bhqkld->bhqkl', q_c, k_sel).astype(f32)
        pos_sel = gidx[..., None] * BLK + blk_pos
        rel_sel = t[None, None, :, None, None] - pos_sel
        s_sel = s_sel + bias_flat[head_off[..., None] + t5_bucket(rel_sel)]
        s_sel = jnp.where(valid[..., None], s_sel, -jnp.inf)
        k_own = lax.dynamic_slice_in_dim(kb, own, 1, axis=2)[:, :, 0]
        v_own = lax.dynamic_slice_in_dim(vb, own, 1, axis=2)[:, :, 0]
        s_own = jnp.einsum('bhqd,bhld->bhql', q_c, k_own).astype(f32)
        rel_own = t[:, None] - (own * BLK + blk_pos)[None, :]
        s_own = s_own + bias_flat[head_off + t5_bucket(rel_own)[None, None]]
        s_own = jnp.where(rel_own[None, None] >= 0, s_own, -jnp.inf)
        logits = jnp.concatenate([s_sel.reshape(B, H, QC, topk * BLK), s_own], axis=-1)
        p = jax.nn.softmax(logits, axis=-1)
        p_sel = p[..., :topk * BLK].reshape(B, H, QC, topk, BLK).astype(v.dtype)
        p_own = p[..., topk * BLK:].astype(v.dtype)
        return (jnp.einsum('bhqkl,bhqkld->bhqd', p_sel, v_sel)
                + jnp.einsum('bhql,bhld->bhqd', p_own, v_own))

    out = lax.map(one_chunk, (jnp.arange(nq, dtype=jnp.int32), q_chunks))
    return out.transpose(1, 0, 3, 2, 4).reshape(B, S, H, hd)


def setup_inputs(seed: int = 0) -> dict:
    key = jax.random.key(seed)
    ks = jax.random.split(key, 16)
    f32 = jnp.float32
    nrm = lambda k, shape, s: (jax.random.normal(k, shape, f32) * s)
    gain = lambda k, shape: 1.0 + 0.05 * jax.random.normal(k, shape, f32)
    return {
        "x": nrm(ks[0], (BATCH, SEQ, D_MODEL), 1.0),
        "c": nrm(ks[1], (BATCH, D_MODEL), 1.0),
        "w_ada": nrm(ks[2], (DEPTH, D_MODEL, N_ADA * D_MODEL), D_MODEL ** -0.5),
        "b_ada": nrm(ks[3], (DEPTH, N_ADA * D_MODEL), 0.02),
        "g_mix": gain(ks[4], (DEPTH, D_MODEL)),
        "w_in": nrm(ks[5], (DEPTH, D_MODEL, D_IN), D_MODEL ** -0.5),
        "w_gla_gate": nrm(ks[6], (DEPTH, GLA_GATE_RANK, GLA_QK_W), GLA_GATE_RANK ** -0.5),
        "b_gla_gate": nrm(ks[7], (DEPTH, GLA_QK_W), 0.1),
        "g_gla_out": gain(ks[8], (DEPTH, GLA_V_W)),
        "rel_bias": nrm(ks[9], (REL_BUCKETS, MOBA_HEADS), 0.5),
        "w_out": nrm(ks[10], (DEPTH, D_MIX, D_MODEL), D_MIX ** -0.5),
        "g_mlp": gain(ks[11], (DEPTH, D_MODEL)),
        "w_ff1": nrm(ks[12], (DEPTH, D_MODEL, D_FF), D_MODEL ** -0.5),
        "w_ff2": nrm(ks[13], (DEPTH, D_FF, D_MODEL), D_FF ** -0.5),
        "g_final": gain(ks[14], (D_MODEL,)),
    }


def reference(x, c, w_ada, b_ada, g_mix, w_in, w_gla_gate, b_gla_gate, g_gla_out, rel_bias,
              w_out, g_mlp, w_ff1, w_ff2, g_final):
    B, S, _ = x.shape
    c_act = jax.nn.silu(c)
    for l in range(DEPTH):
        ada = c_act @ w_ada[l] + b_ada[l]
        shift_a, scale_a, gate_a, shift_m, scale_m, gate_m = jnp.split(ada, N_ADA, axis=-1)
        h = modulate(rmsnorm(x, g_mix[l]), shift_a, scale_a)
        proj = h @ w_in[l]
        gq, gk, gv, gr, gg, mq, mk, mv = jnp.split(proj, IN_SPLITS, axis=-1)
        log_a = jax.nn.log_sigmoid((gg @ w_gla_gate[l] + b_gla_gate[l]).astype(jnp.float32)) / GLA_TAU
        o_gla = gla_mixer(gq.reshape(B, S, GLA_HEADS, GLA_DK), gk.reshape(B, S, GLA_HEADS, GLA_DK),
                          gv.reshape(B, S, GLA_HEADS, GLA_DV), log_a.reshape(B, S, GLA_HEADS, GLA_DK))
        o_gla = rmsnorm(o_gla.astype(x.dtype), g_gla_out[l].reshape(GLA_HEADS, GLA_DV))
        o_gla = o_gla.reshape(B, S, GLA_V_W) * jax.nn.silu(gr)
        o_moba = moba_mixer(mq.reshape(B, S, MOBA_HEADS, MOBA_HD), mk.reshape(B, S, MOBA_HEADS, MOBA_HD),
                            mv.reshape(B, S, MOBA_HEADS, MOBA_HD), rel_bias).reshape(B, S, MOBA_W)
        y = jnp.concatenate([o_gla, o_moba], axis=-1) @ w_out[l]
        x = x + gate_a[:, None, :] * y
        h = modulate(rmsnorm(x, g_mlp[l]), shift_m, scale_m)
        x = x + gate_m[:, None, :] * (jnp.square(jax.nn.relu(h @ w_ff1[l])) @ w_ff2[l])
    return rmsnorm(x, g_final)
```

```cpp
#include <hip/hip_runtime.h>
#include <hip/hip_bf16.h>
#include <cstdio>
#include <cstdint>
#include <cmath>
namespace pg8 {
#define PG8_LAS __attribute__((address_space(3)))
typedef unsigned short bf16_t;
typedef short bf16x8 __attribute__((ext_vector_type(8)));
typedef float f32x4 __attribute__((ext_vector_type(4)));
typedef unsigned u32x4 __attribute__((ext_vector_type(4)));
constexpr int BM = 256, BK = 64, HALF = 128, HTB = HALF * BK * 2  , STAGE_BYTES = 8 * HTB, NXCD = 8, WGM = 8;

__host__ __device__ __forceinline__ int lds_byte(int r, int c) { const int st = (r >> 4) * 2 + (c >> 5), rr = r & 15, cc = c & 31, ob = rr * 64 + cc * 2; return st * 1024 + (ob ^ (((ob >> 9) & 1) << 5)); }
__host__ __device__ __forceinline__ void stage_rc(int b, int& R, int& C) { const int st = b / 1024, sb = b % 1024, swz = sb ^ (((sb >> 9) & 1) << 5); R = (st >> 1) * 16 + swz / 64; C = (st & 1) * 32 + (swz % 64) / 2; }
__host__ __device__ __forceinline__ int perm32(int rho) { const int n = rho >> 4, i = rho & 15; return 8 * (i >> 2) + 4 * n + (i & 3); }

struct Unit { int pm, pn; };
struct Gemm { const bf16_t* A; const bf16_t* Bt; int M, N, K; };

struct StaticOrder {
    int nM, nN, nwg, G, c;
    __host__ __device__ void init(int M, int N, int G_, int c_) { nM = M / BM; nN = N / BM; nwg = nM * nN; G = G_; c = c_; }
    __host__ __device__ bool next(int i, Unit& u) const {
        const long L = (long)i * G + c; if (L >= nwg) return false;
        int wgid = (int)L; { const int q = nwg / NXCD, r = nwg % NXCD, xcd = wgid % NXCD, off = wgid / NXCD; wgid = (xcd < r ? xcd * (q + 1) : r * (q + 1) + (xcd - r) * q) + off; }
        const int nig = WGM * nN, gid = wgid / nig, fm = gid * WGM, gsz = (nM - fm) < WGM ? (nM - fm) : WGM;
        u.pm = fm + ((wgid % nig) % gsz); u.pn = (wgid % nig) / gsz; return true;
    }
    __device__ __forceinline__ void a_ready(const Unit&) const {}
    __device__ __forceinline__ void done(const Unit&) const {}
};

__device__ __forceinline__ unsigned cvt_pk_bf16(float lo, float hi) { unsigned r; asm volatile("v_cvt_pk_bf16_f32 %0, %1, %2" : "=v"(r) : "v"(lo), "v"(hi)); return r; }
typedef float f32x2 __attribute__((ext_vector_type(2)));
typedef float f32x2 __attribute__((ext_vector_type(2)));
constexpr float MOBA_C2 = 0.125f * 1.4426950408889634f;

struct EpiProj {
    static constexpr bool PERM = true, AFTER_DRAIN = false;
    bf16_t* G4; bf16_t* QM; bf16_t* KM; bf16_t* VM; float* LOGA; const float* bgate;
    __device__ __forceinline__ void operator()(const f32x4 (&acc)[2][2][4][2], const Unit& u, int wr, int wc, int fr, int fq) const {
        const int row0 = u.pm * BM + wr * 64 + fr; const int pn = u.pn; const int cl = wc * 32 + 8 * fq;
        if (pn == 12) {
            f32x4 bv[2][2];
#pragma unroll
            for (int bj = 0; bj < 2; ++bj)
#pragma unroll
                for (int n = 0; n < 2; ++n) bv[bj][n] = *(const f32x4*)(bgate + cl + bj * HALF + 4 * n);
#pragma unroll
            for (int ai = 0; ai < 2; ++ai)
#pragma unroll
                for (int m = 0; m < 4; ++m) { float* rowp = LOGA + (size_t)(row0 + ai * HALF + m * 16) * 256 + cl;
#pragma unroll
                    for (int bj = 0; bj < 2; ++bj)
#pragma unroll
                        for (int n = 0; n < 2; ++n) { const f32x4 z = acc[ai][bj][m][n] + bv[bj][n]; f32x4 o;
#pragma unroll
                            for (int e = 0; e < 4; ++e) { const float x = z[e]; o[e] = (fminf(x, 0.f) - __logf(1.f + __expf(-fabsf(x)))) * 0.0625f; }
                            *(f32x4*)(rowp + bj * HALF + 4 * n) = o; } }
        } else {
            bf16_t* base; int ldc, colt; float sc = 1.f;
            if (pn < 6) { base = G4; ldc = 1536; colt = pn * 256; }
            else if (pn < 8) { base = QM; ldc = 512; colt = (pn - 6) * 256; sc = MOBA_C2; }
            else if (pn < 10) { base = KM; ldc = 512; colt = (pn - 8) * 256; }
            else { base = VM; ldc = 512; colt = (pn - 10) * 256; }
            const int col0 = colt + cl;
#pragma unroll
            for (int ai = 0; ai < 2; ++ai)
#pragma unroll
                for (int m = 0; m < 4; ++m) { bf16_t* rowp = base + (size_t)(row0 + ai * HALF + m * 16) * ldc + col0;
#pragma unroll
                    for (int bj = 0; bj < 2; ++bj) { const f32x4 v0 = acc[ai][bj][m][0] * sc, v1 = acc[ai][bj][m][1] * sc;
                        u32x4 w; w.x = cvt_pk_bf16(v0[0], v0[1]); w.y = cvt_pk_bf16(v0[2], v0[3]); w.z = cvt_pk_bf16(v1[0], v1[1]); w.w = cvt_pk_bf16(v1[2], v1[3]);
                        *(u32x4*)(rowp + bj * HALF) = w; } }
        }
    }
};
struct EpiRes {
    static constexpr bool PERM = true, AFTER_DRAIN = false;
    const float* base; float* out; const float* gate; int seq; int gate_ld;
    __device__ __forceinline__ void operator()(const f32x4 (&acc)[2][2][4][2], const Unit& u, int wr, int wc, int fr, int fq) const {
        const int row0 = u.pm * BM + wr * 64 + fr; const int col0 = u.pn * BM + wc * 32 + 8 * fq;
        const float* gp = gate + (size_t)((u.pm * BM) / seq) * gate_ld + col0;
        f32x4 gv[2][2];
#pragma unroll
        for (int bj = 0; bj < 2; ++bj)
#pragma unroll
            for (int n = 0; n < 2; ++n) gv[bj][n] = *(const f32x4*)(gp + bj * HALF + 4 * n);
#pragma unroll
        for (int ai = 0; ai < 2; ++ai)
#pragma unroll
            for (int m = 0; m < 4; ++m) { const size_t off = (size_t)(row0 + ai * HALF + m * 16) * 1024 + col0;
#pragma unroll
                for (int bj = 0; bj < 2; ++bj)
#pragma unroll
                    for (int n = 0; n < 2; ++n) { const f32x4 x = *(const f32x4*)(base + off + bj * HALF + 4 * n);
                        *(f32x4*)(out + off + bj * HALF + 4 * n) = x + gv[bj][n] * acc[ai][bj][m][n]; } }
    }
};
struct EpiRelu2 {
    static constexpr bool PERM = true, AFTER_DRAIN = false;
    bf16_t* O; int ldc;
    __device__ __forceinline__ void operator()(const f32x4 (&acc)[2][2][4][2], const Unit& u, int wr, int wc, int fr, int fq) const {
        const int row0 = u.pm * BM + wr * 64 + fr; const int col0 = u.pn * BM + wc * 32 + 8 * fq;
#pragma unroll
        for (int ai = 0; ai < 2; ++ai)
#pragma unroll
            for (int m = 0; m < 4; ++m) { bf16_t* rowp = O + (size_t)(row0 + ai * HALF + m * 16) * ldc + col0;
#pragma unroll
                for (int bj = 0; bj < 2; ++bj) { f32x4 v0 = acc[ai][bj][m][0], v1 = acc[ai][bj][m][1];
#pragma unroll
                    for (int e = 0; e < 4; ++e) { const float a = fmaxf(v0[e], 0.f), b = fmaxf(v1[e], 0.f); v0[e] = a * a; v1[e] = b * b; }
                    u32x4 w; w.x = cvt_pk_bf16(v0[0], v0[1]); w.y = cvt_pk_bf16(v0[2], v0[3]); w.z = cvt_pk_bf16(v1[0], v1[1]); w.w = cvt_pk_bf16(v1[2], v1[3]);
                    *(u32x4*)(rowp + bj * HALF) = w; } }
    }
};

template <class Epi, class Sched, bool ALIGN_EPI = false, bool SP2 = false>
__device__ __forceinline__ void gemm_phase(PG8_LAS unsigned char* lds, const Gemm g, const Sched& S, const Epi& E) {
    const int tid = threadIdx.x, wid = __builtin_amdgcn_readfirstlane(tid >> 6), lane = tid & 63, wr = wid >> 2, wc = wid & 3, fr = lane & 15, fq = lane >> 4;
    const int K = g.K, nt = K / BK;
    unsigned voffA[2], voffB[2];
#pragma unroll
    for (int i = 0; i < 2; ++i) { int R, C; stage_rc(tid * 16 + i * 8192, R, C); const int Rb = Epi::PERM ? ((R & ~31) + perm32(R & 31)) : R;
        voffA[i] = (unsigned)(R * K + C) * 2u; voffB[i] = (unsigned)(Rb * K + C) * 2u; }
    const size_t kstep = (size_t)(BK * 2);
    const size_t hstep = (size_t)HALF * K * 2;
    const size_t tstep = 2 * hstep;
    const unsigned ldsw = (unsigned)wid * 1024u;
    const int aoff = lds_byte(wr * 64 + fr, fq * 8), boff = lds_byte(wc * 32 + fr, fq * 8);
#define PG8_SA(b, h) (((b) * 2 + (h)) * HTB)
#define PG8_SB(b, h) ((4 + (b) * 2 + (h)) * HTB)
#define PG8_STAGE(bufoff, gbase, voff) do { _Pragma("unroll") for (int _i = 0; _i < 2; ++_i) \
        __builtin_amdgcn_global_load_lds((const unsigned*)((const char*)(gbase) + (voff)[_i]), (PG8_LAS unsigned*)(lds + (bufoff) + ldsw + _i * 8192), 16, 0, 0); } while (0)
#define PG8_LDA(dst, b, h) do { _Pragma("unroll") for (int m = 0; m < 4; ++m) _Pragma("unroll") for (int k = 0; k < 2; ++k) dst[m][k] = *(const PG8_LAS bf16x8*)(lds + PG8_SA(b, h) + aoff + m * 2048 + k * 1024); } while (0)
#define PG8_LDB(dst, b, h) do { _Pragma("unroll") for (int n = 0; n < 2; ++n) _Pragma("unroll") for (int k = 0; k < 2; ++k) dst[n][k] = *(const PG8_LAS bf16x8*)(lds + PG8_SB(b, h) + boff + n * 2048 + k * 1024); } while (0)
#define PG8_MMA(ai, bj, At, Bt) do { __builtin_amdgcn_s_setprio(1); _Pragma("unroll") for (int m = 0; m < 4; ++m) _Pragma("unroll") for (int n = 0; n < 2; ++n) _Pragma("unroll") for (int k = 0; k < 2; ++k) \
        acc[ai][bj][m][n] = __builtin_amdgcn_mfma_f32_16x16x32_bf16(Bt[n][k], At[m][k], acc[ai][bj][m][n], 0, 0, 0); __builtin_amdgcn_s_setprio(0); } while (0)
#define PG8_WAIT_V(n) asm volatile("s_waitcnt vmcnt(" #n ")" ::: "memory")
#define PG8_WAIT_L(n) asm volatile("s_waitcnt lgkmcnt(" #n ")" ::: "memory")
#define PG8_BAR __builtin_amdgcn_s_barrier()
#define PG8_SCHED __builtin_amdgcn_sched_barrier(0)
    Unit cur, nxt; int ui = 0;
    if (!S.next(0, cur)) return;
    f32x4 acc[2][2][4][2];
#pragma unroll
    for (int a = 0; a < 2; ++a)
#pragma unroll
        for (int b = 0; b < 2; ++b)
#pragma unroll
            for (int m = 0; m < 4; ++m)
#pragma unroll
                for (int n = 0; n < 2; ++n) acc[a][b][m][n] = (f32x4){0.f, 0.f, 0.f, 0.f};
    bf16x8 At[4][2], B0[2][2], B1[2][2];
    const char* cA = (const char*)g.A + (size_t)cur.pm * tstep; const char* cB = (const char*)g.Bt + (size_t)cur.pn * tstep;
    S.a_ready(cur);
    if constexpr (SP2) {
        PG8_STAGE(PG8_SB(0, 0), cB, voffB); PG8_STAGE(PG8_SB(0, 1), cB + hstep, voffB); PG8_STAGE(PG8_SA(0, 0), cA, voffA); PG8_STAGE(PG8_SA(0, 1), cA + hstep, voffA);
        if (wr == 1) PG8_BAR;
        PG8_WAIT_V(2); PG8_BAR;
        PG8_STAGE(PG8_SB(1, 0), cB + kstep, voffB); PG8_STAGE(PG8_SA(1, 0), cA + kstep, voffA); PG8_STAGE(PG8_SB(1, 1), cB + hstep + kstep, voffB);
        PG8_WAIT_V(6); PG8_BAR;
    } else {
        PG8_STAGE(PG8_SB(0, 0), cB, voffB); PG8_STAGE(PG8_SA(0, 0), cA, voffA); PG8_STAGE(PG8_SB(0, 1), cB + hstep, voffB); PG8_STAGE(PG8_SA(0, 1), cA + hstep, voffA);
        if (wr == 1) PG8_BAR;
        PG8_WAIT_V(4); PG8_BAR;
        PG8_STAGE(PG8_SB(1, 0), cB + kstep, voffB); PG8_STAGE(PG8_SA(1, 0), cA + kstep, voffA); PG8_STAGE(PG8_SB(1, 1), cB + hstep + kstep, voffB);
        PG8_WAIT_V(6); PG8_BAR;
    }
    for (;;) {
        const bool has_next = S.next(ui + 1, nxt);
        const char* nA = has_next ? (const char*)g.A + (size_t)nxt.pm * tstep : cA; const char* nB = has_next ? (const char*)g.Bt + (size_t)nxt.pn * tstep : cB;
        for (int t = 0; t < nt; t += 2) {
            const bool last = (t == nt - 2);
            const char* a1 = cA + (size_t)(t + 1) * kstep;
            const char* a2 = last ? nA : cA + (size_t)(t + 2) * kstep; const char* b2 = last ? nB : cB + (size_t)(t + 2) * kstep;
            const char* a3 = a2 + kstep; const char* b3 = b2 + kstep;
            if (last && has_next) S.a_ready(nxt);
            if constexpr (SP2) {
            PG8_LDB(B0, 0, 0); PG8_LDB(B1, 0, 1); PG8_SCHED; PG8_LDA(At, 0, 0); PG8_STAGE(PG8_SA(1, 1), a1 + hstep, voffA);
            PG8_WAIT_V(8); PG8_WAIT_L(0); PG8_BAR; PG8_MMA(0, 0, At, B0); PG8_MMA(0, 1, At, B1); PG8_BAR; PG8_SCHED;
            PG8_LDA(At, 0, 1); PG8_STAGE(PG8_SB(0, 0), b2, voffB); PG8_STAGE(PG8_SB(0, 1), b2 + hstep, voffB); PG8_STAGE(PG8_SA(0, 0), a2, voffA);
            PG8_WAIT_V(8); PG8_WAIT_L(0); PG8_BAR; PG8_MMA(1, 0, At, B0); PG8_MMA(1, 1, At, B1); PG8_BAR; PG8_SCHED;
            PG8_LDB(B0, 1, 0); PG8_LDB(B1, 1, 1); PG8_SCHED; PG8_LDA(At, 1, 0); PG8_STAGE(PG8_SA(0, 1), a2 + hstep, voffA);
            PG8_WAIT_V(8); PG8_WAIT_L(0); PG8_BAR; PG8_MMA(0, 0, At, B0); PG8_MMA(0, 1, At, B1); PG8_BAR; PG8_SCHED;
            PG8_LDA(At, 1, 1); PG8_STAGE(PG8_SB(1, 0), b3, voffB); PG8_STAGE(PG8_SB(1, 1), b3 + hstep, voffB); PG8_STAGE(PG8_SA(1, 0), a3, voffA);
            PG8_WAIT_V(8); PG8_WAIT_L(0); PG8_BAR; PG8_MMA(1, 0, At, B0); PG8_MMA(1, 1, At, B1); PG8_BAR; PG8_SCHED;
            } else {
            PG8_LDB(B0, 0, 0); PG8_SCHED; PG8_LDA(At, 0, 0); PG8_STAGE(PG8_SA(1, 1), a1 + hstep, voffA);
            PG8_WAIT_L(8); PG8_BAR; PG8_WAIT_L(0); PG8_MMA(0, 0, At, B0); PG8_BAR; PG8_SCHED;
            PG8_LDB(B1, 0, 1); PG8_STAGE(PG8_SB(0, 0), b2, voffB);
            PG8_BAR; PG8_WAIT_L(0); PG8_MMA(0, 1, At, B1); PG8_BAR;
            PG8_LDA(At, 0, 1); PG8_STAGE(PG8_SA(0, 0), a2, voffA);
            PG8_BAR; PG8_WAIT_L(0); PG8_MMA(1, 0, At, B0); PG8_BAR; PG8_SCHED;
            PG8_STAGE(PG8_SB(0, 1), b2 + hstep, voffB);
            PG8_WAIT_V(6); PG8_BAR; PG8_MMA(1, 1, At, B1); PG8_BAR;
            PG8_LDB(B0, 1, 0); PG8_SCHED; PG8_LDA(At, 1, 0); PG8_STAGE(PG8_SA(0, 1), a2 + hstep, voffA);
            PG8_WAIT_L(8); PG8_BAR; PG8_WAIT_L(0); PG8_MMA(0, 0, At, B0); PG8_BAR; PG8_SCHED;
            PG8_LDB(B1, 1, 1); PG8_STAGE(PG8_SB(1, 0), b3, voffB);
            PG8_BAR; PG8_WAIT_L(0); PG8_MMA(0, 1, At, B1); PG8_BAR;
            PG8_LDA(At, 1, 1); PG8_STAGE(PG8_SA(1, 0), a3, voffA);
            PG8_BAR; PG8_WAIT_L(0); PG8_MMA(1, 0, At, B0); PG8_BAR; PG8_SCHED;
            PG8_STAGE(PG8_SB(1, 1), b3 + hstep, voffB);
            PG8_WAIT_V(6); PG8_BAR; PG8_MMA(1, 1, At, B1); PG8_BAR;
            }
        }
        if constexpr (ALIGN_EPI) { if (wr == 0) PG8_BAR; }
        if constexpr (!Epi::AFTER_DRAIN) { E(acc, cur, wr, wc, fr, fq); S.done(cur); }
        if (!has_next) break;
#pragma unroll
        for (int a = 0; a < 2; ++a)
#pragma unroll
            for (int b = 0; b < 2; ++b)
#pragma unroll
                for (int m = 0; m < 4; ++m)
#pragma unroll
                    for (int n = 0; n < 2; ++n) acc[a][b][m][n] = (f32x4){0.f, 0.f, 0.f, 0.f};
        cur = nxt; cA = nA; cB = nB; ++ui;
        if constexpr (ALIGN_EPI) { if (wr == 1) PG8_BAR; }
    }
    PG8_WAIT_V(0);
    if constexpr (!ALIGN_EPI) { if (wr == 0) PG8_BAR; }
    PG8_BAR;
    if constexpr (Epi::AFTER_DRAIN) { E.fused(acc, cur, wr, wc, fr, fq, lds, wid, lane); S.done(cur); }
#undef PG8_SA
#undef PG8_SB
#undef PG8_STAGE
#undef PG8_LDA
#undef PG8_LDB
#undef PG8_MMA
#undef PG8_WAIT_V
#undef PG8_WAIT_L
#undef PG8_BAR
#undef PG8_SCHED
}
}
#define GAS __attribute__((address_space(1)))
#define LAS __attribute__((address_space(3)))
typedef unsigned short bf16;
typedef unsigned v4u __attribute__((ext_vector_type(4)));
typedef float f32x4 __attribute__((ext_vector_type(4)));
typedef short bf16x8 __attribute__((ext_vector_type(8)));
typedef GAS unsigned gu32;
typedef GAS unsigned long long gu64;
#define RLX_AGENT __ATOMIC_RELAXED, __HIP_MEMORY_SCOPE_AGENT
#define LDS_WAIT() asm volatile("s_waitcnt lgkmcnt(0)" ::: "memory")
#define VM_WAIT() asm volatile("s_waitcnt vmcnt(0)" ::: "memory")
__device__ __forceinline__ unsigned long long rt() { return __builtin_amdgcn_s_memrealtime(); }
__device__ __forceinline__ unsigned f2bf(float f) { unsigned u = __builtin_bit_cast(unsigned, f); return (u + 0x7fffu + ((u >> 16) & 1u)) >> 16; }
__device__ __forceinline__ unsigned pk2(float lo, float hi) { return f2bf(lo) | (f2bf(hi) << 16); }
#define XB_TMO      128
#define XB_XCNT(j)  (256  + 64 * (j))
#define XB_XSUB(j)  (1280 + 64 * (j))
#define XB_XGEN(j)  (2304 + 64 * (j))
#define XB_TOP      3328
#define XB_TOPGEN   3392
#define XCD_BAR_WORDS 3456
#define XB_SPIN_CAP (1u << 18)

__device__ __forceinline__ unsigned xb_ld(unsigned* p)              { return __hip_atomic_load(p, __ATOMIC_RELAXED, __HIP_MEMORY_SCOPE_AGENT); }
__device__ __forceinline__ unsigned xb_add(unsigned* p, unsigned v) { return __hip_atomic_fetch_add(p, v, __ATOMIC_RELAXED, __HIP_MEMORY_SCOPE_AGENT); }
__device__ __forceinline__ unsigned xb_xcc_id() { return (unsigned)__builtin_amdgcn_s_getreg((3 << 11) | 20) & 0xFu; }
#define XB_SPIN(cond, bar) do { unsigned _sp = 0; while (cond) { __builtin_amdgcn_s_sleep(1); \
    if ((++_sp & 255u) == 0u) { if (xb_ld(&(bar)[XB_TMO])) break; if (_sp > XB_SPIN_CAP) { atomicAdd(&(bar)[XB_TMO], 1u); break; } } } } while (0)

struct XcdBarrier {
    unsigned* bar; unsigned x;
    volatile LAS unsigned* st;
};

__device__ __forceinline__ XcdBarrier xcd_barrier_post(unsigned* bar, volatile LAS unsigned* st) {
    XcdBarrier b; b.bar = bar; b.x = xb_xcc_id(); b.st = st;
    if (threadIdx.x == 0) (void)xb_add(&bar[XB_XCNT(b.x)], 1u);
    return b;
}
__device__ __forceinline__ void xcd_barrier_complete(unsigned* bar, unsigned x, unsigned& nloc, unsigned& nx) {
    const unsigned G = gridDim.x * gridDim.y * gridDim.z;
    unsigned sum, cnt, mine, sp = 0u;
    for (;;) {
        sum = 0u; cnt = 0u; mine = 0u;
#pragma unroll
        for (unsigned j = 0; j < 16; ++j) { const unsigned c = xb_ld(&bar[XB_XCNT(j)]); sum += c; cnt += (c > 0u) ? 1u : 0u; mine = (j == x) ? c : mine; }
        if (sum == G) break;
        __builtin_amdgcn_s_sleep(1);
        if ((++sp & 255u) == 0u) { if (xb_ld(&bar[XB_TMO])) break; if (sp > XB_SPIN_CAP) { atomicAdd(&bar[XB_TMO], 1u); break; } }
    }
    nloc = mine > 0u ? mine : 1u; nx = cnt > 0u ? cnt : 1u;
}

__device__ __forceinline__ void xcd_barrier(const XcdBarrier& b) {
    asm volatile("s_waitcnt vmcnt(0)" ::: "memory");
    __syncthreads();
    if (threadIdx.x == 0) {
        unsigned* bar = b.bar;
        __builtin_amdgcn_s_waitcnt(0);
        unsigned nloc = b.st[0], nx = b.st[1];
        if (nloc == 0u) { xcd_barrier_complete(bar, b.x, nloc, nx); b.st[0] = nloc; b.st[1] = nx; }
        const unsigned old = xb_add(&bar[XB_XSUB(b.x)], 1u);
        const unsigned gen = old / nloc;
        if (old + 1u == (gen + 1u) * nloc) {
            __builtin_amdgcn_fence(__ATOMIC_RELEASE, "agent");
            asm volatile("s_waitcnt vmcnt(0)" ::: "memory");
            const unsigned og = xb_add(&bar[XB_TOP], 1u);
            const unsigned tg = og / nx;
            if (og + 1u == (tg + 1u) * nx) xb_add(&bar[XB_TOPGEN], 1u);
            else XB_SPIN(xb_ld(&bar[XB_TOPGEN]) == tg, bar);
            __builtin_amdgcn_fence(__ATOMIC_ACQUIRE, "agent");
            xb_add(&bar[XB_XGEN(b.x)], 1u);
            asm volatile("s_waitcnt vmcnt(0)" ::: "memory");
        } else {
            XB_SPIN(xb_ld(&bar[XB_XGEN(b.x)]) == gen, bar);
            __builtin_amdgcn_fence(__ATOMIC_ACQUIRE, "agent");
            asm volatile("s_waitcnt vmcnt(0)" ::: "memory");
        }
    }
    __syncthreads();
}

constexpr int NWAVES = 8;
#ifndef MK_N_LAUNCHES
#define MK_N_LAUNCHES 1
#endif
constexpr int N_PHASES = 9;
constexpr int N_LAUNCHES = MK_N_LAUNCHES;
constexpr int BATCH = 32, SEQ = 2048, D = 1024, FF = 4096, M = BATCH * SEQ;
constexpr int NPROJ = 3328;
constexpr int W_IN_LD = 3088, ADA_LD = 6 * D;
constexpr float EPS = 1e-6f, LOG2E = 1.4426950408889634f;

constexpr size_t MiB = 1u << 20;
constexpr size_t WS_CTL = 0, CTL_ZERO_BYTES = 1 * MiB;
constexpr size_t WS_ADA = 1 * MiB;
constexpr size_t WS_WIN = 2 * MiB, WS_WOUT = 9 * MiB, WS_W1 = 11 * MiB, WS_W2 = 19 * MiB;
constexpr size_t WS_XN = 32 * MiB;
constexpr size_t WS_G4 = 160 * MiB;
constexpr size_t WS_QM = 352 * MiB, WS_KM = 416 * MiB, WS_VM = 480 * MiB;
constexpr size_t WS_LOGA = 544 * MiB;
constexpr size_t WS_U = 160 * MiB;
constexpr size_t WS_MIX = 736 * MiB;
constexpr size_t WS_END = 864 * MiB;
static_assert(WS_U + (size_t)M * FF * 2 <= WS_MIX && WS_LOGA + (size_t)M * 256 * 4 <= WS_MIX && WS_W2 + (size_t)D * FF * 2 <= WS_XN, "d_ws map");
constexpr int CW_TMO = 0, CW_CODE = 1, CW_BAR = 4096;

constexpr int RING_OFF = 0, RING_BYTES = 131072;
constexpr int LDSCTL_OFF = RING_BYTES, MISC_OFF = LDSCTL_OFF + 320;
constexpr int LDS_BYTES = 147456;
static_assert(MISC_OFF + 128 <= LDS_BYTES, "LDS map");

struct Frame {
    LAS unsigned char* lds;
    volatile LAS unsigned* MISC;
    gu32* ctl;
    int tid, lane, wave;
    int vcu, G;
};

__device__ __forceinline__ float wave_sum(float v) {
#pragma unroll
    for (int o = 1; o < 64; o <<= 1) v += __shfl_xor(v, o);
    return v;
}
__device__ __forceinline__ float bf2f(unsigned short u) { return __uint_as_float((unsigned)u << 16); }
typedef float f32x2_t __attribute__((ext_vector_type(2))); typedef __bf16 bf16x2_t __attribute__((ext_vector_type(2)));
__device__ __forceinline__ unsigned cvtpk_s(float lo, float hi) { f32x2_t v = {lo, hi}; bf16x2_t b = __builtin_convertvector(v, bf16x2_t); return __builtin_bit_cast(unsigned, b); }
__device__ __forceinline__ unsigned short f2bf_s(float f) { return (unsigned short)(cvtpk_s(f, 0.f) & 0xffffu); }
typedef float f32x16 __attribute__((ext_vector_type(16)));
typedef short s16x4 __attribute__((ext_vector_type(4)));
typedef short v4i16_t __attribute__((ext_vector_type(4)));
#define MFMA32(a, b, c) __builtin_amdgcn_mfma_f32_32x32x16_bf16((a), (b), (c), 0, 0, 0)
__device__ __forceinline__ int crow(int reg, int h) { return (reg & 3) + 8 * (reg >> 2) + 4 * h; }
#define PACK8(x, s) __builtin_bit_cast(bf16x8, (v4u){cvtpk_s((x)[8 * (s)], (x)[8 * (s) + 1]), cvtpk_s((x)[8 * (s) + 2], (x)[8 * (s) + 3]), cvtpk_s((x)[8 * (s) + 4], (x)[8 * (s) + 5]), cvtpk_s((x)[8 * (s) + 6], (x)[8 * (s) + 7])})
__device__ __forceinline__ s16x4 tr_read(const LAS unsigned char* p) { return __builtin_bit_cast(s16x4, __builtin_amdgcn_ds_read_tr16_b64_v4i16((LAS v4i16_t*)p)); }
__device__ __forceinline__ bf16x8 cat8(s16x4 lo, s16x4 hi) { return __builtin_shufflevector(lo, hi, 0, 1, 2, 3, 4, 5, 6, 7); }

__device__ __forceinline__ void transpose_item(const float* W, int ldw, int nblk, bf16* WT, int K, int row_off, LAS float* scr, int item, int lane) {
    const int kb = item / nblk, nb = item % nblk, k0 = 64 * kb, n0 = 32 * nb;
#pragma unroll 8
    for (int i = 0; i < 32; ++i) { const int kk = 2 * i + (lane >> 5); scr[kk * 33 + (lane & 31)] = W[(size_t)(k0 + kk) * ldw + n0 + (lane & 31)]; }
    LDS_WAIT(); asm volatile("" ::: "memory");
    const int c = lane & 7;
#pragma unroll
    for (int j = 0; j < 4; ++j) { const int n = (lane >> 3) + 8 * j; const LAS float* s = scr + (8 * c) * 33 + n;
        v4u o; o.x = pk2(s[0 * 33], s[1 * 33]); o.y = pk2(s[2 * 33], s[3 * 33]); o.z = pk2(s[4 * 33], s[5 * 33]); o.w = pk2(s[6 * 33], s[7 * 33]);
        *(GAS v4u*)(WT + (size_t)(row_off + n0 + n) * K + k0 + 8 * c) = o; }
    LDS_WAIT(); asm volatile("" ::: "memory");
}
struct Ptrs {
    const float *x, *c, *w_ada, *b_ada, *g_mix, *w_in, *w_gate, *b_gate, *g_gla, *rel_bias, *w_out, *g_mlp, *w_ff1, *w_ff2, *g_final;
    float* out; float* ada; float* loga;
    bf16 *Win_t, *Wout_t, *W1_t, *W2_t, *XN, *G4, *QM, *KM, *VM, *U, *MIX;
};
__device__ __forceinline__ void p0_prologue(Frame& F, const Ptrs& P) {
    LAS float* scr = (LAS float*)(F.lds + RING_OFF + F.wave * 16384);
    const int gw = F.vcu * NWAVES + F.wave, NGW = F.G * NWAVES;
    for (int it = F.G - 1 - (int)blockIdx.x; it < ADA_LD / 64; it += F.G) {
        const int n0 = it * 64, kbase = 128 * F.wave;
#pragma unroll 4
        for (int i = 0; i < 64; ++i) { const int b = (F.lane >> 3) + 8 * (i & 3), kk = (F.lane & 7) + 8 * (i >> 2);
            const float cv = P.c[b * D + kbase + kk]; scr[kk * 32 + b] = cv / (1.f + __expf(-cv)); }
        LDS_WAIT(); asm volatile("" ::: "memory");
        float acc[32];
#pragma unroll
        for (int b = 0; b < 32; ++b) acc[b] = 0.f;
#pragma unroll 4
        for (int kk = 0; kk < 128; ++kk) { const float w = P.w_ada[(size_t)(kbase + kk) * ADA_LD + n0 + F.lane];
#pragma unroll
            for (int g = 0; g < 8; ++g) { const f32x4 cv = *(const LAS f32x4*)(scr + kk * 32 + 4 * g);
                acc[4 * g] += cv[0] * w; acc[4 * g + 1] += cv[1] * w; acc[4 * g + 2] += cv[2] * w; acc[4 * g + 3] += cv[3] * w; } }
        __syncthreads();
        LAS float* red = (LAS float*)(F.lds + RING_OFF);
#pragma unroll
        for (int b = 0; b < 32; ++b) red[(F.wave * 32 + b) * 64 + F.lane] = acc[b];
        __syncthreads();
#pragma unroll
        for (int o = 0; o < 4; ++o) { const int idx = F.tid + 512 * o, b = idx >> 6, n = idx & 63; float s = P.b_ada[n0 + n];
#pragma unroll
            for (int w = 0; w < 8; ++w) s += red[(w * 32 + b) * 64 + n];
            P.ada[b * ADA_LD + n0 + n] = s; }
        __syncthreads();
    }
    constexpr int I_IN = (D / 64) * 48, I_OUT = (D / 64) * (D / 32), I_1 = (D / 64) * (FF / 32), I_2 = (FF / 64) * (D / 32), I_G = 16 * 8;
    constexpr int NITEMS = 2 * I_IN + I_OUT + I_1 + I_2 + I_G;
    for (int it = gw; it < NITEMS; it += NGW) {
        int r = it;
        if (r < I_IN) { transpose_item(P.w_in, W_IN_LD, 48, P.Win_t, D, 0, scr, r, F.lane); continue; } r -= I_IN;
        if (r < I_IN) { transpose_item(P.w_in + 1552, W_IN_LD, 48, P.Win_t, D, 1536, scr, r, F.lane); continue; } r -= I_IN;
        if (r < I_OUT) { transpose_item(P.w_out, D, D / 32, P.Wout_t, D, 0, scr, r, F.lane); continue; } r -= I_OUT;
        if (r < I_1) { transpose_item(P.w_ff1, FF, FF / 32, P.W1_t, D, 0, scr, r, F.lane); continue; } r -= I_1;
        if (r < I_2) { transpose_item(P.w_ff2, D, D / 32, P.W2_t, FF, 0, scr, r, F.lane); continue; } r -= I_2;
        { const int kb = r >> 3, jb = r & 7, k = 64 * kb + F.lane; float a[16];
#pragma unroll
          for (int q = 0; q < 4; ++q) { const f32x4 v = *(const f32x4*)(P.w_in + (size_t)k * W_IN_LD + 1536 + 4 * q); a[4 * q] = v[0]; a[4 * q + 1] = v[1]; a[4 * q + 2] = v[2]; a[4 * q + 3] = v[3]; }
          for (int jj = 0; jj < 32; ++jj) { const int j = 32 * jb + jj; float s = 0.f;
#pragma unroll
              for (int q = 0; q < 16; ++q) s += a[q] * P.w_gate[q * 256 + j];
              P.Win_t[(size_t)(3072 + j) * D + k] = (bf16)f2bf(s); } }
    }
}

template <int MODE> __device__ __forceinline__ void norm_phase(Frame& F, const float* src, bf16* dst_bf, float* dst_f, const float* g, const float* ada, int shift_off, int scale_off) {
    const int gw = F.vcu * NWAVES + F.wave, NGW = F.G * NWAVES;
    for (int rb = gw; rb < M / 32; rb += NGW) {
        const int row0 = rb * 32, b = row0 / SEQ;
        f32x4 ca[4], cb[4];
#pragma unroll
        for (int j = 0; j < 4; ++j) { const int col = 4 * F.lane + 256 * j; const f32x4 gg = *(const f32x4*)(g + col);
            if (MODE == 0) { const f32x4 sc = *(const f32x4*)(ada + (size_t)b * ADA_LD + scale_off + col), sh = *(const f32x4*)(ada + (size_t)b * ADA_LD + shift_off + col);
                ca[j] = gg * (1.f + sc); cb[j] = sh; }
            else { ca[j] = gg; cb[j] = (f32x4){0.f, 0.f, 0.f, 0.f}; } }
#pragma unroll 2
        for (int rr = 0; rr < 32; ++rr) { const size_t row = (size_t)(row0 + rr);
            const GAS f32x4* xr = (const GAS f32x4*)(src + row * D) + F.lane;
            f32x4 v[4]; float s = 0.f;
#pragma unroll
            for (int j = 0; j < 4; ++j) { v[j] = xr[64 * j]; s += (v[j].x * v[j].x + v[j].y * v[j].y) + (v[j].z * v[j].z + v[j].w * v[j].w); }
            const float rstd = 1.f / sqrtf(wave_sum(s) * (1.f / D) + EPS);
            if (MODE == 0) { GAS unsigned long long* o8 = (GAS unsigned long long*)(dst_bf + row * D) + F.lane;
#pragma unroll
                for (int j = 0; j < 4; ++j) { const f32x4 y = v[j] * rstd * ca[j] + cb[j];
                    o8[64 * j] = (unsigned long long)cvtpk_s(y.x, y.y) | ((unsigned long long)cvtpk_s(y.z, y.w) << 32); } }
            else { GAS f32x4* o = (GAS f32x4*)(dst_f + row * D) + F.lane;
#pragma unroll
                for (int j = 0; j < 4; ++j) o[64 * j] = v[j] * rstd * ca[j]; }
        }
    }
}

constexpr int GST = 144;
constexpr int GL_QT = 0, GL_KT = 9216, GL_KTT = 18432, GL_VT = 27648, GL_TOT = 46080, GL_SSQ = 48128, GL_VEC = 49152;
__device__ __forceinline__ void gla_task(Frame& F, const Ptrs& P, int task) {
    const int b = task >> 2, h = task & 3;
    LAS unsigned char* L = F.lds + RING_OFF;
    const int w = F.wave, lane = F.lane, r = lane & 31, hh = lane >> 5;
    LAS float* TOT = (LAS float*)(L + GL_TOT); LAS float* SSQ = (LAS float*)(L + GL_SSQ); LAS float* VEC = (LAS float*)(L + GL_VEC);
    f32x16 S0, S1;
#pragma unroll
    for (int i = 0; i < 16; ++i) { S0[i] = 0.f; S1[i] = 0.f; }
    const float gout = (w < 4) ? P.g_gla[h * 128 + 32 * w + r] : 0.f;
    for (int c = 0; c < SEQ / 64; ++c) {
        const size_t t0 = (size_t)b * SEQ + (size_t)c * 64;
        float cs[8]; unsigned short qv[8], kv[8];
        { float run = 0.f;
#pragma unroll
          for (int i = 0; i < 8; ++i) { const size_t tr = t0 + 8 * w + i; run += P.loga[tr * 256 + h * 64 + lane]; cs[i] = run;
              qv[i] = P.G4[tr * 1536 + h * 64 + lane]; kv[i] = P.G4[tr * 1536 + 256 + h * 64 + lane]; }
          TOT[w * 64 + lane] = run; }
#pragma unroll
        for (int half = 0; half < 2; ++half) { const int vc = lane + 64 * half; unsigned short u[8];
#pragma unroll
            for (int i = 0; i < 8; ++i) u[i] = P.G4[(t0 + 8 * w + i) * 1536 + 512 + h * 128 + vc];
            v4u pk; pk.x = u[0] | ((unsigned)u[1] << 16); pk.y = u[2] | ((unsigned)u[3] << 16); pk.z = u[4] | ((unsigned)u[5] << 16); pk.w = u[6] | ((unsigned)u[7] << 16);
            *(LAS v4u*)(L + GL_VT + vc * GST + 16 * w) = pk; }
        __syncthreads();
        float off = 0.f, bref = 0.f, blast = 0.f;
#pragma unroll
        for (int ww = 0; ww < 8; ++ww) { const float t = TOT[ww * 64 + lane]; off += (ww < w) ? t : 0.f; bref += (ww < 4) ? t : 0.f; blast += t; }
        { unsigned short kp[8];
#pragma unroll
          for (int i = 0; i < 8; ++i) { const float bi = cs[i] + off; const float E = __expf(bi - bref), Ei = __expf(bref - bi);
              const unsigned short qb = f2bf_s(bf2f(qv[i]) * 0.125f * E), kb = f2bf_s(bf2f(kv[i]) * Ei);
              *(LAS unsigned short*)(L + GL_QT + (8 * w + i) * GST + 2 * lane) = qb; *(LAS unsigned short*)(L + GL_KT + (8 * w + i) * GST + 2 * lane) = kb; kp[i] = kb; }
          v4u pk; pk.x = kp[0] | ((unsigned)kp[1] << 16); pk.y = kp[2] | ((unsigned)kp[3] << 16); pk.z = kp[4] | ((unsigned)kp[5] << 16); pk.w = kp[6] | ((unsigned)kp[7] << 16);
          *(LAS v4u*)(L + GL_KTT + lane * GST + 16 * w) = pk; }
        if (w == 0) { VEC[lane] = __expf(bref); VEC[64 + lane] = __expf(blast); VEC[128 + lane] = __expf(blast - bref); }
        __syncthreads();
        f32x16 o0, o1;
        if (w < 4) {
            unsigned short grv[32];
#pragma unroll
            for (int it = 0; it < 2; ++it)
#pragma unroll
                for (int i = 0; i < 16; ++i) grv[it * 16 + i] = P.G4[(t0 + 32 * it + crow(i, hh)) * 1536 + 1024 + h * 128 + 32 * w + r];
            f32x16 X00, X01, X11;
#pragma unroll
            for (int i = 0; i < 16; ++i) { X00[i] = 0.f; X01[i] = 0.f; X11[i] = 0.f; o0[i] = 0.f; o1[i] = 0.f; }
#pragma unroll
            for (int d0 = 0; d0 < 4; ++d0) {
                const bf16x8 k0f = *(const LAS bf16x8*)(L + GL_KT + r * GST + 32 * d0 + 16 * hh), k1f = *(const LAS bf16x8*)(L + GL_KT + (32 + r) * GST + 32 * d0 + 16 * hh);
                const bf16x8 q0f = *(const LAS bf16x8*)(L + GL_QT + r * GST + 32 * d0 + 16 * hh), q1f = *(const LAS bf16x8*)(L + GL_QT + (32 + r) * GST + 32 * d0 + 16 * hh);
                X00 = MFMA32(k0f, q0f, X00); X01 = MFMA32(k0f, q1f, X01); X11 = MFMA32(k1f, q1f, X11); }
#pragma unroll
            for (int i = 0; i < 16; ++i) { const bool keep = crow(i, hh) <= r; X00[i] = keep ? X00[i] : 0.f; X11[i] = keep ? X11[i] : 0.f; }
            const LAS unsigned char* vrow = L + GL_VT + (32 * w + r) * GST;
#pragma unroll
            for (int s = 0; s < 2; ++s) {
                const bf16x8 v0f = cat8(*(const LAS s16x4*)(vrow + 2 * (16 * s + 4 * hh)), *(const LAS s16x4*)(vrow + 2 * (16 * s + 8 + 4 * hh)));
                const bf16x8 v1f = cat8(*(const LAS s16x4*)(vrow + 2 * (32 + 16 * s + 4 * hh)), *(const LAS s16x4*)(vrow + 2 * (32 + 16 * s + 8 + 4 * hh)));
                o0 = MFMA32(PACK8(X00, s), v0f, o0); o1 = MFMA32(PACK8(X01, s), v0f, o1); o1 = MFMA32(PACK8(X11, s), v1f, o1); }
            { f32x16 T0, T1;
#pragma unroll
              for (int g = 0; g < 4; ++g) { const f32x4 e0 = *(const LAS f32x4*)(VEC + 8 * g + 4 * hh), e1 = *(const LAS f32x4*)(VEC + 32 + 8 * g + 4 * hh);
#pragma unroll
                  for (int e = 0; e < 4; ++e) { T0[4 * g + e] = S0[4 * g + e] * e0[e]; T1[4 * g + e] = S1[4 * g + e] * e1[e]; } }
              const LAS unsigned char* q0row = L + GL_QT + r * GST; const LAS unsigned char* q1row = L + GL_QT + (32 + r) * GST;
#pragma unroll
              for (int s = 0; s < 2; ++s) {
                  const bf16x8 sb0 = PACK8(T0, s), sb1 = PACK8(T1, s);
                  const bf16x8 qa00 = cat8(*(const LAS s16x4*)(q0row + 2 * (16 * s + 4 * hh)), *(const LAS s16x4*)(q0row + 2 * (16 * s + 8 + 4 * hh)));
                  const bf16x8 qa01 = cat8(*(const LAS s16x4*)(q0row + 2 * (32 + 16 * s + 4 * hh)), *(const LAS s16x4*)(q0row + 2 * (32 + 16 * s + 8 + 4 * hh)));
                  const bf16x8 qa10 = cat8(*(const LAS s16x4*)(q1row + 2 * (16 * s + 4 * hh)), *(const LAS s16x4*)(q1row + 2 * (16 * s + 8 + 4 * hh)));
                  const bf16x8 qa11 = cat8(*(const LAS s16x4*)(q1row + 2 * (32 + 16 * s + 4 * hh)), *(const LAS s16x4*)(q1row + 2 * (32 + 16 * s + 8 + 4 * hh)));
                  o0 = MFMA32(qa00, sb0, o0); o0 = MFMA32(qa01, sb1, o0); o1 = MFMA32(qa10, sb0, o1); o1 = MFMA32(qa11, sb1, o1); } }
            { f32x16 kv0, kv1;
#pragma unroll
              for (int i = 0; i < 16; ++i) { kv0[i] = 0.f; kv1[i] = 0.f; }
#pragma unroll
              for (int tt = 0; tt < 4; ++tt) { const bf16x8 vb = *(const LAS bf16x8*)(vrow + 32 * tt + 16 * hh);
                  const bf16x8 ka0 = *(const LAS bf16x8*)(L + GL_KTT + r * GST + 32 * tt + 16 * hh), ka1 = *(const LAS bf16x8*)(L + GL_KTT + (32 + r) * GST + 32 * tt + 16 * hh);
                  kv0 = MFMA32(ka0, vb, kv0); kv1 = MFMA32(ka1, vb, kv1); }
#pragma unroll
              for (int g = 0; g < 4; ++g) { const f32x4 dc0 = *(const LAS f32x4*)(VEC + 64 + 8 * g + 4 * hh), dc1 = *(const LAS f32x4*)(VEC + 64 + 32 + 8 * g + 4 * hh);
                  const f32x4 d10 = *(const LAS f32x4*)(VEC + 128 + 8 * g + 4 * hh), d11 = *(const LAS f32x4*)(VEC + 128 + 32 + 8 * g + 4 * hh);
#pragma unroll
                  for (int e = 0; e < 4; ++e) { S0[4 * g + e] = dc0[e] * S0[4 * g + e] + d10[e] * kv0[4 * g + e]; S1[4 * g + e] = dc1[e] * S1[4 * g + e] + d11[e] * kv1[4 * g + e]; } } }
            { float a[32];
#pragma unroll
              for (int i = 0; i < 16; ++i) { a[i] = o0[i] * o0[i]; a[16 + i] = o1[i] * o1[i]; }
#pragma unroll
              for (int st = 16; st >= 1; st >>= 1) { const bool up = (lane & st) != 0;
#pragma unroll
                  for (int k = 0; k < st; ++k) { const float send = up ? a[k] : a[k + st], keep = up ? a[k + st] : a[k]; a[k] = keep + __shfl_xor(send, st); } }
              SSQ[w * 64 + 32 * (r >> 4) + crow(r & 15, hh)] = a[0]; }
#pragma unroll
            for (int i = 0; i < 16; ++i) { const float g0 = bf2f(grv[i]), g1 = bf2f(grv[16 + i]); o0[i] *= g0 / (1.f + __expf(-g0)); o1[i] *= g1 / (1.f + __expf(-g1)); }
        }
        __syncthreads();
        if (w < 4) {
#pragma unroll
            for (int it = 0; it < 2; ++it)
#pragma unroll
                for (int g = 0; g < 4; ++g) { f32x4 tot = *(const LAS f32x4*)(SSQ + 32 * it + 8 * g + 4 * hh);
#pragma unroll
                    for (int ww = 1; ww < 4; ++ww) tot += *(const LAS f32x4*)(SSQ + ww * 64 + 32 * it + 8 * g + 4 * hh);
#pragma unroll
                    for (int e = 0; e < 4; ++e) { const int i = 4 * g + e; const float rstd = 1.f / sqrtf(tot[e] * (1.f / 128.f) + EPS);
                        const float y = (it == 0 ? o0[i] : o1[i]) * rstd * gout;
                        P.MIX[(t0 + 32 * it + crow(i, hh)) * 1024 + h * 128 + 32 * w + r] = (bf16)f2bf_s(y); } }
        }
    }
    __syncthreads();
}

constexpr int ML_KM = 0, ML_BIAS = 2048, ML_WSF = 3072, ML_K = 4096, ML_V = 4096 + 2 * 9216, ML_END = 4096 + 4 * 9216;
__device__ __forceinline__ void moba_task(Frame& F, const Ptrs& P, int task) {
    const int b = task >> 3, h = task & 7;
    LAS unsigned char* L = F.lds + RING_OFF;
    const int w = F.wave, lane = F.lane, r = lane & 31, hh = lane >> 5, tid = F.tid;
    LAS float* KMl = (LAS float*)(L + ML_KM); LAS float* BIASl = (LAS float*)(L + ML_BIAS); LAS float* WSFw = (LAS float*)(L + ML_WSF) + 32 * w;
    { const bf16* Kp = P.KM + ((size_t)b * SEQ + 256 * w) * 512 + h * 64; const int ch = lane & 7, rg = lane >> 3; float a[8];
#pragma unroll
      for (int e = 0; e < 8; ++e) a[e] = 0.f;
#pragma unroll 4
      for (int it = 0; it < 32; ++it) { const v4u v = *(const v4u*)(Kp + (size_t)(8 * it + rg) * 512 + ch * 8);
          a[0] += __uint_as_float(v.x << 16); a[1] += __uint_as_float(v.x & 0xffff0000u); a[2] += __uint_as_float(v.y << 16); a[3] += __uint_as_float(v.y & 0xffff0000u);
          a[4] += __uint_as_float(v.z << 16); a[5] += __uint_as_float(v.z & 0xffff0000u); a[6] += __uint_as_float(v.w << 16); a[7] += __uint_as_float(v.w & 0xffff0000u); }
#pragma unroll
      for (int e = 0; e < 8; ++e) { a[e] += __shfl_xor(a[e], 8); a[e] += __shfl_xor(a[e], 16); a[e] += __shfl_xor(a[e], 32); }
      if (lane < 8) {
#pragma unroll
          for (int e = 0; e < 8; ++e) KMl[w * 64 + ch * 8 + e] = a[e] * (1.f / 256.f); } }
    if (tid <= 128) { const int n = tid; int bk;
        if (n < 16) bk = n; else { bk = 16 + (int)(__logf((float)n * (1.f / 16.f)) / 2.0794415416798357f * 16.f); bk = bk > 31 ? 31 : bk; }
        BIASl[n] = P.rel_bias[bk * 8 + h] * LOG2E; }
    __syncthreads();
    const float b31 = BIASl[128];
    const int srow = tid >> 3, sch = tid & 7;
    const bf16* Kg = P.KM + (size_t)b * SEQ * 512 + h * 64 + sch * 8; const bf16* Vg = P.VM + (size_t)b * SEQ * 512 + h * 64 + sch * 8;
    const int q4 = (lane & 15) >> 2, p4 = lane & 3, blk = (lane >> 4) & 1;
    for (int qi = 0; qi < 8; ++qi) {
        const int qb = (qi & 1) ? (qi >> 1) : 7 - (qi >> 1);
        const int q0 = qb * 256; const size_t qrow = (size_t)b * SEQ + q0 + 32 * w + r;
        bf16x8 qr[4];
#pragma unroll
        for (int d0 = 0; d0 < 4; ++d0) qr[d0] = *(const bf16x8*)(P.QM + qrow * 512 + h * 64 + 16 * d0 + 8 * hh);
        float gt[8];
#pragma unroll
        for (int j = 0; j < 8; ++j) { float s = 0.f;
#pragma unroll
            for (int d0 = 0; d0 < 4; ++d0) { const f32x4 m0 = *(const LAS f32x4*)(KMl + j * 64 + 16 * d0 + 8 * hh), m1 = *(const LAS f32x4*)(KMl + j * 64 + 16 * d0 + 8 * hh + 4);
#pragma unroll
                for (int e = 0; e < 4; ++e) { s += bf2f((unsigned short)qr[d0][e]) * m0[e]; s += bf2f((unsigned short)qr[d0][4 + e]) * m1[e]; } }
            gt[j] = s + __shfl_xor(s, 32); }
        unsigned sel = 1u << qb;
#pragma unroll
        for (int j = 0; j < 8; ++j) { int rank = 0;
#pragma unroll
            for (int j2 = 0; j2 < 8; ++j2) if (j2 != j) rank += (j2 < qb && (gt[j2] > gt[j] || (gt[j2] == gt[j] && j2 < j))) ? 1 : 0;
            if (j < qb && rank < 3) sel |= 1u << j; }
        const int NT = 4 * (qb + 1);
        float mref = 0.f, lsum = 0.f; f32x16 o0, o1;
#pragma unroll
        for (int i = 0; i < 16; ++i) { o0[i] = 0.f; o1[i] = 0.f; }
        v4u kreg, vreg;
        kreg = *(const v4u*)(Kg + (size_t)srow * 512); vreg = *(const v4u*)(Vg + (size_t)srow * 512);
        *(LAS v4u*)(L + ML_K + srow * GST + sch * 16) = kreg; *(LAS v4u*)(L + ML_V + srow * GST + sch * 16) = vreg;
        __syncthreads();
        for (int n = 0; n < NT; ++n) {
            if (n + 1 < NT) { kreg = *(const v4u*)(Kg + (size_t)((n + 1) * 64 + srow) * 512); vreg = *(const v4u*)(Vg + (size_t)((n + 1) * 64 + srow) * 512); }
            const int j = n >> 2, kt = n & 3; const LAS unsigned char* Kb = L + ML_K + (n & 1) * 9216; const LAS unsigned char* Vb = L + ML_V + (n & 1) * 9216;
            const bool mysel = ((sel >> j) & 1u) != 0u;
            const bool selw = __any(mysel ? 1 : 0) != 0;
            const bool cskip = (j == qb) && (kt * 64 > 32 * w + 31);
            if (selw && !cskip) {
                const bool nearb = (j == qb) || (j == qb - 1 && kt >= 2);
                const float cinv = mysel ? (nearb ? -mref : (b31 - mref)) : -INFINITY;
                f32x16 p0, p1;
#pragma unroll
                for (int i = 0; i < 16; ++i) { p0[i] = cinv; p1[i] = cinv; }
#pragma unroll
                for (int d0 = 0; d0 < 4; ++d0) { const bf16x8 a0 = *(const LAS bf16x8*)(Kb + r * GST + 32 * d0 + 16 * hh), a1 = *(const LAS bf16x8*)(Kb + (32 + r) * GST + 32 * d0 + 16 * hh);
                    p0 = MFMA32(a0, qr[d0], p0); p1 = MFMA32(a1, qr[d0], p1); }
                if (nearb) { const int qabs = q0 + 32 * w + r, kb0 = 64 * n;
#pragma unroll
                    for (int i = 0; i < 16; ++i) { const int d0_ = qabs - (kb0 + crow(i, hh)), d1_ = d0_ - 32;
                        const float bb0 = BIASl[min(max(d0_, 0), 128)], bb1 = BIASl[min(max(d1_, 0), 128)];
                        p0[i] = d0_ < 0 ? -INFINITY : p0[i] + bb0; p1[i] = d1_ < 0 ? -INFINITY : p1[i] + bb1; } }
                float rm = fmaxf(p0[0], p1[0]);
#pragma unroll
                for (int i = 1; i < 16; ++i) rm = fmaxf(rm, fmaxf(p0[i], p1[i]));
                rm = fmaxf(rm, __shfl_xor(rm, 32));
                if (__any(rm > 8.f ? 1 : 0)) { const float dl = fmaxf(rm, 0.f); mref += dl;
#pragma unroll
                    for (int i = 0; i < 16; ++i) { p0[i] -= dl; p1[i] -= dl; }
                    const float f = __builtin_amdgcn_exp2f(-dl); lsum *= f;
                    asm volatile("" ::: "memory"); if (hh == 0) WSFw[r] = f; asm volatile("" ::: "memory");
#pragma unroll
                    for (int g = 0; g < 4; ++g) { const f32x4 fv = *(const LAS f32x4*)(WSFw + 8 * g + 4 * hh);
#pragma unroll
                        for (int e = 0; e < 4; ++e) { o0[4 * g + e] *= fv[e]; o1[4 * g + e] *= fv[e]; } }
                    asm volatile("" ::: "memory"); }
                float ls = 0.f;
#pragma unroll
                for (int i = 0; i < 16; ++i) { p0[i] = __builtin_amdgcn_exp2f(p0[i]); p1[i] = __builtin_amdgcn_exp2f(p1[i]); ls += p0[i] + p1[i]; }
                lsum += ls;
#pragma unroll
                for (int s = 0; s < 2; ++s) { const bf16x8 pa0 = PACK8(p0, s), pa1 = PACK8(p1, s);
#pragma unroll
                    for (int d0 = 0; d0 < 2; ++d0) { const int cb = 2 * (32 * d0 + 16 * blk + 4 * p4);
                        const bf16x8 vb0 = cat8(tr_read(Vb + (16 * s + 4 * hh + q4) * GST + cb), tr_read(Vb + (16 * s + 8 + 4 * hh + q4) * GST + cb));
                        const bf16x8 vb1 = cat8(tr_read(Vb + (32 + 16 * s + 4 * hh + q4) * GST + cb), tr_read(Vb + (32 + 16 * s + 8 + 4 * hh + q4) * GST + cb));
                        if (d0 == 0) { o0 = MFMA32(pa0, vb0, o0); o0 = MFMA32(pa1, vb1, o0); } else { o1 = MFMA32(pa0, vb0, o1); o1 = MFMA32(pa1, vb1, o1); } } }
            }
            if (n + 1 < NT) { *(LAS v4u*)(L + ML_K + ((n + 1) & 1) * 9216 + srow * GST + sch * 16) = kreg; *(LAS v4u*)(L + ML_V + ((n + 1) & 1) * 9216 + srow * GST + sch * 16) = vreg; }
            __syncthreads();
        }
        { const float lt = lsum + __shfl_xor(lsum, 32);
          asm volatile("" ::: "memory"); if (hh == 0) WSFw[r] = 1.f / lt; asm volatile("" ::: "memory");
#pragma unroll
          for (int g = 0; g < 4; ++g) { const f32x4 fv = *(const LAS f32x4*)(WSFw + 8 * g + 4 * hh);
#pragma unroll
              for (int e = 0; e < 4; ++e) { const int i = 4 * g + e; bf16* op = P.MIX + ((size_t)b * SEQ + q0 + 32 * w + crow(i, hh)) * 1024 + 512 + h * 64 + r;
                  op[0] = (bf16)f2bf_s(o0[i] * fv[e]); op[32] = (bf16)f2bf_s(o1[i] * fv[e]); } }
          asm volatile("" ::: "memory"); }
    }
    __syncthreads();
}

struct Args { const float* in[15]; float* out; unsigned char* ws; int ph_lo, ph_hi; };
__global__ void __launch_bounds__(NWAVES * 64, 2) hybrid_fwd(Args args) {
    extern __shared__ __attribute__((aligned(16))) unsigned char lds[];
    Frame F;
    F.lds = (LAS unsigned char*)lds;
    F.MISC = (volatile LAS unsigned*)(F.lds + MISC_OFF);
    F.tid = threadIdx.x; F.lane = F.tid & 63; F.wave = __builtin_amdgcn_readfirstlane(F.tid >> 6);
    F.G = gridDim.x; { const int bx = blockIdx.x; F.vcu = (F.G % 8 == 0) ? (bx % 8) * (F.G / 8) + bx / 8 : bx; }
    unsigned char* ws = args.ws;
    F.ctl = (gu32*)(ws + WS_CTL);
    Ptrs P;
    P.x = args.in[0]; P.c = args.in[1]; P.w_ada = args.in[2]; P.b_ada = args.in[3]; P.g_mix = args.in[4]; P.w_in = args.in[5]; P.w_gate = args.in[6]; P.b_gate = args.in[7];
    P.g_gla = args.in[8]; P.rel_bias = args.in[9]; P.w_out = args.in[10]; P.g_mlp = args.in[11]; P.w_ff1 = args.in[12]; P.w_ff2 = args.in[13]; P.g_final = args.in[14];
    P.out = args.out; P.ada = (float*)(ws + WS_ADA); P.loga = (float*)(ws + WS_LOGA);
    P.Win_t = (bf16*)(ws + WS_WIN); P.Wout_t = (bf16*)(ws + WS_WOUT); P.W1_t = (bf16*)(ws + WS_W1); P.W2_t = (bf16*)(ws + WS_W2);
    P.XN = (bf16*)(ws + WS_XN); P.G4 = (bf16*)(ws + WS_G4); P.QM = (bf16*)(ws + WS_QM); P.KM = (bf16*)(ws + WS_KM); P.VM = (bf16*)(ws + WS_VM); P.U = (bf16*)(ws + WS_U); P.MIX = (bf16*)(ws + WS_MIX);
    for (int u = F.tid; u < (LDS_BYTES - LDSCTL_OFF) / 4; u += NWAVES * 64) ((LAS unsigned*)(F.lds + LDSCTL_OFF))[u] = 0u;
    __syncthreads();
    XcdBarrier bar; bar.bar = (unsigned*)(F.ctl + CW_BAR); bar.x = 0; bar.st = nullptr;
    if (N_LAUNCHES == 1) bar = xcd_barrier_post((unsigned*)(F.ctl + CW_BAR), F.MISC + 8);
#define GRID_BAR(seam) do { if (N_LAUNCHES != 1) { if (F.tid == 0) __hip_atomic_store(F.ctl + CW_TMO, 0xBADBA0u | (unsigned)(seam), RLX_AGENT); } else { xcd_barrier(bar); } } while (0)
    const int lo = args.ph_lo, hi = args.ph_hi;
#define IN(k) (lo <= (k) && (k) < hi)
#define BOTH(k) (IN(k) && IN((k) + 1))

    if (IN(0)) { p0_prologue(F, P); if (BOTH(0)) GRID_BAR(0); }
    if (IN(1)) { norm_phase<0>(F, P.x, P.XN, nullptr, P.g_mix, P.ada, 0, D); if (BOTH(1)) GRID_BAR(1); }
    if (IN(2)) {
        pg8::Gemm g{P.XN, P.Win_t, M, NPROJ, D}; pg8::StaticOrder S; S.init(M, NPROJ, F.G, (int)blockIdx.x);
        pg8::EpiProj E{P.G4, P.QM, P.KM, P.VM, P.loga, P.b_gate};
        pg8::gemm_phase<pg8::EpiProj, pg8::StaticOrder, true, true>(F.lds + RING_OFF, g, S, E);
        if (BOTH(2)) GRID_BAR(2);
    }
    if (IN(3)) {
        for (int t = blockIdx.x; t < BATCH * 4; t += F.G) gla_task(F, P, t);
        for (int t = blockIdx.x; t < BATCH * 8; t += F.G) moba_task(F, P, t);
        if (BOTH(3)) GRID_BAR(3);
    }
    if (IN(4)) {
        pg8::Gemm g{P.MIX, P.Wout_t, M, D, D}; pg8::StaticOrder S; S.init(M, D, F.G, (int)blockIdx.x);
        pg8::EpiRes E{P.x, P.out, P.ada + 2 * D, SEQ, ADA_LD};
        pg8::gemm_phase<pg8::EpiRes, pg8::StaticOrder, true, true>(F.lds + RING_OFF, g, S, E);
        if (BOTH(4)) GRID_BAR(4);
    }
    if (IN(5)) { norm_phase<0>(F, P.out, P.XN, nullptr, P.g_mlp, P.ada, 3 * D, 4 * D); if (BOTH(5)) GRID_BAR(5); }
    if (IN(6)) {
        pg8::Gemm g{P.XN, P.W1_t, M, FF, D}; pg8::StaticOrder S; S.init(M, FF, F.G, (int)blockIdx.x);
        pg8::EpiRelu2 E{P.U, FF};
        pg8::gemm_phase<pg8::EpiRelu2, pg8::StaticOrder, true, true>(F.lds + RING_OFF, g, S, E);
        if (BOTH(6)) GRID_BAR(6);
    }
    if (IN(7)) {
        pg8::Gemm g{P.U, P.W2_t, M, D, FF}; pg8::StaticOrder S; S.init(M, D, F.G, (int)blockIdx.x);
        pg8::EpiRes E{P.out, P.out, P.ada + 5 * D, SEQ, ADA_LD};
        pg8::gemm_phase<pg8::EpiRes, pg8::StaticOrder, true, true>(F.lds + RING_OFF, g, S, E);
        if (BOTH(7)) GRID_BAR(7);
    }
    if (IN(8)) { norm_phase<1>(F, P.out, nullptr, P.out, P.g_final, nullptr, 0, 0); }
#undef IN
#undef BOTH
}

extern "C" void kernel_launch(void* const* d_in, const int* in_sizes, int n_in, void* d_out, int out_size, void* d_ws, size_t ws_size, hipStream_t stream) {
    static int grid = 0;
    if (grid == 0) {
        if (n_in != 15 || in_sizes[0] != M * D || out_size != M * D || ws_size < WS_END) { fprintf(stderr, "kernel_launch: unexpected shapes (n_in %d, in0 %d, out %d, ws %zu); nothing launched\n", n_in, n_in > 0 ? in_sizes[0] : -1, out_size, ws_size); grid = -1; return; }
        int dev = 0, cus = 0, per_cu = 0;
        if (hipGetDevice(&dev) != hipSuccess || hipDeviceGetAttribute(&cus, hipDeviceAttributeMultiprocessorCount, dev) != hipSuccess) { fprintf(stderr, "kernel_launch: device query failed\n"); grid = -1; return; }
        if (hipFuncSetAttribute((const void*)hybrid_fwd, hipFuncAttributeMaxDynamicSharedMemorySize, LDS_BYTES) != hipSuccess) { fprintf(stderr, "kernel_launch: hipFuncSetAttribute failed\n"); grid = -1; return; }
        if (hipOccupancyMaxActiveBlocksPerMultiprocessor(&per_cu, (const void*)hybrid_fwd, NWAVES * 64, LDS_BYTES) != hipSuccess || per_cu < 1)
            fprintf(stderr, "kernel_launch: note: occupancy query reports %d workgroups per CU\n", per_cu);
        (void)hipGetLastError();
        grid = cus;
    }
    if (grid < 0) return;
    if (hipMemsetAsync((char*)d_ws + WS_CTL, 0, CTL_ZERO_BYTES, stream) != hipSuccess) { fprintf(stderr, "kernel_launch: memset failed\n"); return; }
    Args a{};
    for (int i = 0; i < 15; ++i) a.in[i] = (const float*)d_in[i];
    a.out = (float*)d_out; a.ws = (unsigned char*)d_ws;
    for (int li = 0; li < N_LAUNCHES; ++li) {
        a.ph_lo = (N_LAUNCHES == 1) ? 0 : li; a.ph_hi = (N_LAUNCHES == 1) ? N_PHASES : li + 1;
        hipLaunchKernelGGL(hybrid_fwd, dim3(grid), dim3(NWAVES * 64), LDS_BYTES, stream, a);
        const hipError_t le = hipPeekAtLastError();
        if (le != hipSuccess) { fprintf(stderr, "kernel_launch: launch %d failed: %s\n", li, hipGetErrorName(le)); break; }
    }
}
```

```cpp
#include <hip/hip_runtime.h>
#include <hip/hip_bf16.h>
#include <cstdio>
#include <cstdint>
#include <cmath>
namespace pg8 {
#define PG8_LAS __attribute__((address_space(3)))
typedef unsigned short bf16_t;
typedef short bf16x8 __attribute__((ext_vector_type(8)));
typedef float f32x4 __attribute__((ext_vector_type(4)));
typedef unsigned u32x4 __attribute__((ext_vector_type(4)));
constexpr int BM = 256, BK = 64, HALF = 128, HTB = HALF * BK * 2  , STAGE_BYTES = 8 * HTB, NXCD = 8, WGM = 8;

__host__ __device__ __forceinline__ int lds_byte(int r, int c) { const int st = (r >> 4) * 2 + (c >> 5), rr = r & 15, cc = c & 31, ob = rr * 64 + cc * 2; return st * 1024 + (ob ^ (((ob >> 9) & 1) << 5)); }
__host__ __device__ __forceinline__ void stage_rc(int b, int& R, int& C) { const int st = b / 1024, sb = b % 1024, swz = sb ^ (((sb >> 9) & 1) << 5); R = (st >> 1) * 16 + swz / 64; C = (st & 1) * 32 + (swz % 64) / 2; }
__host__ __device__ __forceinline__ int perm32(int rho) { const int n = rho >> 4, i = rho & 15; return 8 * (i >> 2) + 4 * n + (i & 3); }

struct Unit { int pm, pn; };
struct Gemm { const bf16_t* A; const bf16_t* Bt; int M, N, K; };

struct StaticOrder {
    int nM, nN, nwg, G, c;
    __host__ __device__ void init(int M, int N, int G_, int c_) { nM = M / BM; nN = N / BM; nwg = nM * nN; G = G_; c = c_; }
    __host__ __device__ bool next(int i, Unit& u) const {
        const long L = (long)i * G + c; if (L >= nwg) return false;
        int wgid = (int)L; { const int q = nwg / NXCD, r = nwg % NXCD, xcd = wgid % NXCD, off = wgid / NXCD; wgid = (xcd < r ? xcd * (q + 1) : r * (q + 1) + (xcd - r) * q) + off; }
        const int nig = WGM * nN, gid = wgid / nig, fm = gid * WGM, gsz = (nM - fm) < WGM ? (nM - fm) : WGM;
        u.pm = fm + ((wgid % nig) % gsz); u.pn = (wgid % nig) / gsz; return true;
    }
    __device__ __forceinline__ void a_ready(const Unit&) const {}
    __device__ __forceinline__ void done(const Unit&) const {}
};

__device__ __forceinline__ unsigned cvt_pk_bf16(float lo, float hi) { unsigned r; asm volatile("v_cvt_pk_bf16_f32 %0, %1, %2" : "=v"(r) : "v"(lo), "v"(hi)); return r; }
typedef float f32x2 __attribute__((ext_vector_type(2)));
typedef float f32x2 __attribute__((ext_vector_type(2)));
constexpr float MOBA_C2 = 0.125f * 1.4426950408889634f;

struct EpiProj {
    static constexpr bool PERM = true, AFTER_DRAIN = false;
    bf16_t* G4; bf16_t* QM; bf16_t* KM; bf16_t* VM; float* LOGA; const float* bgate;
    __device__ __forceinline__ void operator()(const f32x4 (&acc)[2][2][4][2], const Unit& u, int wr, int wc, int fr, int fq) const {
        const int row0 = u.pm * BM + wr * 64 + fr; const int pn = u.pn; const int cl = wc * 32 + 8 * fq;
        if (pn == 12) {
            f32x4 bv[2][2];
#pragma unroll
            for (int bj = 0; bj < 2; ++bj)
#pragma unroll
                for (int n = 0; n < 2; ++n) bv[bj][n] = *(const f32x4*)(bgate + cl + bj * HALF + 4 * n);
#pragma unroll
            for (int ai = 0; ai < 2; ++ai)
#pragma unroll
                for (int m = 0; m < 4; ++m) { float* rowp = LOGA + (size_t)(row0 + ai * HALF + m * 16) * 256 + cl;
#pragma unroll
                    for (int bj = 0; bj < 2; ++bj)
#pragma unroll
                        for (int n = 0; n < 2; ++n) { const f32x4 z = acc[ai][bj][m][n] + bv[bj][n]; f32x4 o;
#pragma unroll
                            for (int e = 0; e < 4; ++e) { const float x = z[e]; o[e] = (fminf(x, 0.f) - __logf(1.f + __expf(-fabsf(x)))) * 0.0625f; }
                            *(f32x4*)(rowp + bj * HALF + 4 * n) = o; } }
        } else {
            bf16_t* base; int ldc, colt; float sc = 1.f;
            if (pn < 6) { base = G4; ldc = 1536; colt = pn * 256; }
            else if (pn < 8) { base = QM; ldc = 512; colt = (pn - 6) * 256; sc = MOBA_C2; }
            else if (pn < 10) { base = KM; ldc = 512; colt = (pn - 8) * 256; }
            else { base = VM; ldc = 512; colt = (pn - 10) * 256; }
            const int col0 = colt + cl;
#pragma unroll
            for (int ai = 0; ai < 2; ++ai)
#pragma unroll
                for (int m = 0; m < 4; ++m) { bf16_t* rowp = base + (size_t)(row0 + ai * HALF + m * 16) * ldc + col0;
#pragma unroll
                    for (int bj = 0; bj < 2; ++bj) { const f32x4 v0 = acc[ai][bj][m][0] * sc, v1 = acc[ai][bj][m][1] * sc;
                        u32x4 w; w.x = cvt_pk_bf16(v0[0], v0[1]); w.y = cvt_pk_bf16(v0[2], v0[3]); w.z = cvt_pk_bf16(v1[0], v1[1]); w.w = cvt_pk_bf16(v1[2], v1[3]);
                        *(u32x4*)(rowp + bj * HALF) = w; } }
        }
    }
};
struct EpiRes {
    static constexpr bool PERM = true, AFTER_DRAIN = false;
    const float* base; float* out; const float* gate; int seq; int gate_ld;
    __device__ __forceinline__ void operator()(const f32x4 (&acc)[2][2][4][2], const Unit& u, int wr, int wc, int fr, int fq) const {
        const int row0 = u.pm * BM + wr * 64 + fr; const int col0 = u.pn * BM + wc * 32 + 8 * fq;
        const float* gp = gate + (size_t)((u.pm * BM) / seq) * gate_ld + col0;
        f32x4 gv[2][2];
#pragma unroll
        for (int bj = 0; bj < 2; ++bj)
#pragma unroll
            for (int n = 0; n < 2; ++n) gv[bj][n] = *(const f32x4*)(gp + bj * HALF + 4 * n);
        f32x4 xb[2][2][2];
#pragma unroll
        for (int bj = 0; bj < 2; ++bj)
#pragma unroll
            for (int n = 0; n < 2; ++n) xb[0][bj][n] = *(const f32x4*)(base + (size_t)row0 * 1024 + col0 + bj * HALF + 4 * n);
#pragma unroll
        for (int g = 0; g < 8; ++g) { const int ai = g >> 2, m = g & 3; const size_t off = (size_t)(row0 + ai * HALF + m * 16) * 1024 + col0;
            if (g + 1 < 8) { const int ai2 = (g + 1) >> 2, m2 = (g + 1) & 3; const size_t off2 = (size_t)(row0 + ai2 * HALF + m2 * 16) * 1024 + col0;
#pragma unroll
                for (int bj = 0; bj < 2; ++bj)
#pragma unroll
                    for (int n = 0; n < 2; ++n) xb[(g + 1) & 1][bj][n] = *(const f32x4*)(base + off2 + bj * HALF + 4 * n); }
#pragma unroll
            for (int bj = 0; bj < 2; ++bj)
#pragma unroll
                for (int n = 0; n < 2; ++n) *(f32x4*)(out + off + bj * HALF + 4 * n) = xb[g & 1][bj][n] + gv[bj][n] * acc[ai][bj][m][n]; }
    }
};
struct EpiRelu2 {
    static constexpr bool PERM = true, AFTER_DRAIN = false;
    bf16_t* O; int ldc;
    __device__ __forceinline__ void operator()(const f32x4 (&acc)[2][2][4][2], const Unit& u, int wr, int wc, int fr, int fq) const {
        const int row0 = u.pm * BM + wr * 64 + fr; const int col0 = u.pn * BM + wc * 32 + 8 * fq;
#pragma unroll
        for (int ai = 0; ai < 2; ++ai)
#pragma unroll
            for (int m = 0; m < 4; ++m) { bf16_t* rowp = O + (size_t)(row0 + ai * HALF + m * 16) * ldc + col0;
#pragma unroll
                for (int bj = 0; bj < 2; ++bj) { f32x4 v0 = acc[ai][bj][m][0], v1 = acc[ai][bj][m][1];
#pragma unroll
                    for (int e = 0; e < 4; ++e) { const float a = fmaxf(v0[e], 0.f), b = fmaxf(v1[e], 0.f); v0[e] = a * a; v1[e] = b * b; }
                    u32x4 w; w.x = cvt_pk_bf16(v0[0], v0[1]); w.y = cvt_pk_bf16(v0[2], v0[3]); w.z = cvt_pk_bf16(v1[0], v1[1]); w.w = cvt_pk_bf16(v1[2], v1[3]);
                    *(u32x4*)(rowp + bj * HALF) = w; } }
    }
};

template <class Epi, class Sched, bool ALIGN_EPI = false, bool SP2 = false>
__device__ __forceinline__ void gemm_phase(PG8_LAS unsigned char* lds, const Gemm g, const Sched& S, const Epi& E) {
    const int tid = threadIdx.x, wid = __builtin_amdgcn_readfirstlane(tid >> 6), lane = tid & 63, wr = wid >> 2, wc = wid & 3, fr = lane & 15, fq = lane >> 4;
    const int K = g.K, nt = K / BK;
    unsigned voffA[2], voffB[2];
#pragma unroll
    for (int i = 0; i < 2; ++i) { int R, C; stage_rc(tid * 16 + i * 8192, R, C); const int Rb = Epi::PERM ? ((R & ~31) + perm32(R & 31)) : R;
        voffA[i] = (unsigned)(R * K + C) * 2u; voffB[i] = (unsigned)(Rb * K + C) * 2u; }
    const size_t kstep = (size_t)(BK * 2);
    const size_t hstep = (size_t)HALF * K * 2;
    const size_t tstep = 2 * hstep;
    const unsigned ldsw = (unsigned)wid * 1024u;
    const int aoff = lds_byte(wr * 64 + fr, fq * 8), boff = lds_byte(wc * 32 + fr, fq * 8);
#define PG8_SA(b, h) (((b) * 2 + (h)) * HTB)
#define PG8_SB(b, h) ((4 + (b) * 2 + (h)) * HTB)
#define PG8_STAGE(bufoff, gbase, voff) do { _Pragma("unroll") for (int _i = 0; _i < 2; ++_i) \
        __builtin_amdgcn_global_load_lds((const unsigned*)((const char*)(gbase) + (voff)[_i]), (PG8_LAS unsigned*)(lds + (bufoff) + ldsw + _i * 8192), 16, 0, 0); } while (0)
#define PG8_LDA(dst, b, h) do { _Pragma("unroll") for (int m = 0; m < 4; ++m) _Pragma("unroll") for (int k = 0; k < 2; ++k) dst[m][k] = *(const PG8_LAS bf16x8*)(lds + PG8_SA(b, h) + aoff + m * 2048 + k * 1024); } while (0)
#define PG8_LDB(dst, b, h) do { _Pragma("unroll") for (int n = 0; n < 2; ++n) _Pragma("unroll") for (int k = 0; k < 2; ++k) dst[n][k] = *(const PG8_LAS bf16x8*)(lds + PG8_SB(b, h) + boff + n * 2048 + k * 1024); } while (0)
#define PG8_MMA(ai, bj, At, Bt) do { __builtin_amdgcn_s_setprio(1); _Pragma("unroll") for (int m = 0; m < 4; ++m) _Pragma("unroll") for (int n = 0; n < 2; ++n) _Pragma("unroll") for (int k = 0; k < 2; ++k) \
        acc[ai][bj][m][n] = __builtin_amdgcn_mfma_f32_16x16x32_bf16(Bt[n][k], At[m][k], acc[ai][bj][m][n], 0, 0, 0); __builtin_amdgcn_s_setprio(0); } while (0)
#define PG8_WAIT_V(n) asm volatile("s_waitcnt vmcnt(" #n ")" ::: "memory")
#define PG8_WAIT_L(n) asm volatile("s_waitcnt lgkmcnt(" #n ")" ::: "memory")
#define PG8_BAR __builtin_amdgcn_s_barrier()
#define PG8_SCHED __builtin_amdgcn_sched_barrier(0)
    Unit cur, nxt; int ui = 0;
    if (!S.next(0, cur)) return;
    f32x4 acc[2][2][4][2];
#pragma unroll
    for (int a = 0; a < 2; ++a)
#pragma unroll
        for (int b = 0; b < 2; ++b)
#pragma unroll
            for (int m = 0; m < 4; ++m)
#pragma unroll
                for (int n = 0; n < 2; ++n) acc[a][b][m][n] = (f32x4){0.f, 0.f, 0.f, 0.f};
    bf16x8 At[4][2], B0[2][2], B1[2][2];
    const char* cA = (const char*)g.A + (size_t)cur.pm * tstep; const char* cB = (const char*)g.Bt + (size_t)cur.pn * tstep;
    S.a_ready(cur);
    if constexpr (SP2) {
        PG8_STAGE(PG8_SB(0, 0), cB, voffB); PG8_STAGE(PG8_SB(0, 1), cB + hstep, voffB); PG8_STAGE(PG8_SA(0, 0), cA, voffA); PG8_STAGE(PG8_SA(0, 1), cA + hstep, voffA);
        if (wr == 1) PG8_BAR;
        PG8_WAIT_V(2); PG8_BAR;
        PG8_STAGE(PG8_SB(1, 0), cB + kstep, voffB); PG8_STAGE(PG8_SA(1, 0), cA + kstep, voffA); PG8_STAGE(PG8_SB(1, 1), cB + hstep + kstep, voffB);
        PG8_WAIT_V(6); PG8_BAR;
    } else {
        PG8_STAGE(PG8_SB(0, 0), cB, voffB); PG8_STAGE(PG8_SA(0, 0), cA, voffA); PG8_STAGE(PG8_SB(0, 1), cB + hstep, voffB); PG8_STAGE(PG8_SA(0, 1), cA + hstep, voffA);
        if (wr == 1) PG8_BAR;
        PG8_WAIT_V(4); PG8_BAR;
        PG8_STAGE(PG8_SB(1, 0), cB + kstep, voffB); PG8_STAGE(PG8_SA(1, 0), cA + kstep, voffA); PG8_STAGE(PG8_SB(1, 1), cB + hstep + kstep, voffB);
        PG8_WAIT_V(6); PG8_BAR;
    }
    for (;;) {
        const bool has_next = S.next(ui + 1, nxt);
        const char* nA = has_next ? (const char*)g.A + (size_t)nxt.pm * tstep : cA; const char* nB = has_next ? (const char*)g.Bt + (size_t)nxt.pn * tstep : cB;
        for (int t = 0; t < nt; t += 2) {
            const bool last = (t == nt - 2);
            const char* a1 = cA + (size_t)(t + 1) * kstep;
            const char* a2 = last ? nA : cA + (size_t)(t + 2) * kstep; const char* b2 = last ? nB : cB + (size_t)(t + 2) * kstep;
            const char* a3 = a2 + kstep; const char* b3 = b2 + kstep;
            if (last && has_next) S.a_ready(nxt);
            if constexpr (SP2) {
            PG8_LDB(B0, 0, 0); PG8_LDB(B1, 0, 1); PG8_SCHED; PG8_LDA(At, 0, 0); PG8_STAGE(PG8_SA(1, 1), a1 + hstep, voffA);
            PG8_WAIT_V(8); PG8_WAIT_L(0); PG8_BAR; PG8_MMA(0, 0, At, B0); PG8_MMA(0, 1, At, B1); PG8_BAR; PG8_SCHED;
            PG8_LDA(At, 0, 1); PG8_STAGE(PG8_SB(0, 0), b2, voffB); PG8_STAGE(PG8_SB(0, 1), b2 + hstep, voffB); PG8_STAGE(PG8_SA(0, 0), a2, voffA);
            PG8_WAIT_V(8); PG8_WAIT_L(0); PG8_BAR; PG8_MMA(1, 0, At, B0); PG8_MMA(1, 1, At, B1); PG8_BAR; PG8_SCHED;
            PG8_LDB(B0, 1, 0); PG8_LDB(B1, 1, 1); PG8_SCHED; PG8_LDA(At, 1, 0); PG8_STAGE(PG8_SA(0, 1), a2 + hstep, voffA);
            PG8_WAIT_V(8); PG8_WAIT_L(0); PG8_BAR; PG8_MMA(0, 0, At, B0); PG8_MMA(0, 1, At, B1); PG8_BAR; PG8_SCHED;
            PG8_LDA(At, 1, 1); PG8_STAGE(PG8_SB(1, 0), b3, voffB); PG8_STAGE(PG8_SB(1, 1), b3 + hstep, voffB); PG8_STAGE(PG8_SA(1, 0), a3, voffA);
            PG8_WAIT_V(8); PG8_WAIT_L(0); PG8_BAR; PG8_MMA(1, 0, At, B0); PG8_MMA(1, 1, At, B1); PG8_BAR; PG8_SCHED;
            } else {
            PG8_LDB(B0, 0, 0); PG8_SCHED; PG8_LDA(At, 0, 0); PG8_STAGE(PG8_SA(1, 1), a1 + hstep, voffA);
            PG8_WAIT_L(8); PG8_BAR; PG8_WAIT_L(0); PG8_MMA(0, 0, At, B0); PG8_BAR; PG8_SCHED;
            PG8_LDB(B1, 0, 1); PG8_STAGE(PG8_SB(0, 0), b2, voffB);
            PG8_BAR; PG8_WAIT_L(0); PG8_MMA(0, 1, At, B1); PG8_BAR;
            PG8_LDA(At, 0, 1); PG8_STAGE(PG8_SA(0, 0), a2, voffA);
            PG8_BAR; PG8_WAIT_L(0); PG8_MMA(1, 0, At, B0); PG8_BAR; PG8_SCHED;
            PG8_STAGE(PG8_SB(0, 1), b2 + hstep, voffB);
            PG8_WAIT_V(6); PG8_BAR; PG8_MMA(1, 1, At, B1); PG8_BAR;
            PG8_LDB(B0, 1, 0); PG8_SCHED; PG8_LDA(At, 1, 0); PG8_STAGE(PG8_SA(0, 1), a2 + hstep, voffA);
            PG8_WAIT_L(8); PG8_BAR; PG8_WAIT_L(0); PG8_MMA(0, 0, At, B0); PG8_BAR; PG8_SCHED;
            PG8_LDB(B1, 1, 1); PG8_STAGE(PG8_SB(1, 0), b3, voffB);
            PG8_BAR; PG8_WAIT_L(0); PG8_MMA(0, 1, At, B1); PG8_BAR;
            PG8_LDA(At, 1, 1); PG8_STAGE(PG8_SA(1, 0), a3, voffA);
            PG8_BAR; PG8_WAIT_L(0); PG8_MMA(1, 0, At, B0); PG8_BAR; PG8_SCHED;
            PG8_STAGE(PG8_SB(1, 1), b3 + hstep, voffB);
            PG8_WAIT_V(6); PG8_BAR; PG8_MMA(1, 1, At, B1); PG8_BAR;
            }
        }
        if constexpr (ALIGN_EPI) { if (wr == 0) PG8_BAR; }
        if constexpr (!Epi::AFTER_DRAIN) { E(acc, cur, wr, wc, fr, fq); S.done(cur); }
        if (!has_next) break;
#pragma unroll
        for (int a = 0; a < 2; ++a)
#pragma unroll
            for (int b = 0; b < 2; ++b)
#pragma unroll
                for (int m = 0; m < 4; ++m)
#pragma unroll
                    for (int n = 0; n < 2; ++n) acc[a][b][m][n] = (f32x4){0.f, 0.f, 0.f, 0.f};
        cur = nxt; cA = nA; cB = nB; ++ui;
        if constexpr (ALIGN_EPI) { if (wr == 1) PG8_BAR; }
    }
    PG8_WAIT_V(0);
    if constexpr (!ALIGN_EPI) { if (wr == 0) PG8_BAR; }
    PG8_BAR;
    if constexpr (Epi::AFTER_DRAIN) { E.fused(acc, cur, wr, wc, fr, fq, lds, wid, lane); S.done(cur); }
#undef PG8_SA
#undef PG8_SB
#undef PG8_STAGE
#undef PG8_LDA
#undef PG8_LDB
#undef PG8_MMA
#undef PG8_WAIT_V
#undef PG8_WAIT_L
#undef PG8_BAR
#undef PG8_SCHED
}
}
#define GAS __attribute__((address_space(1)))
#define LAS __attribute__((address_space(3)))
typedef unsigned short bf16;
typedef unsigned v4u __attribute__((ext_vector_type(4)));
typedef float f32x4 __attribute__((ext_vector_type(4)));
typedef short bf16x8 __attribute__((ext_vector_type(8)));
typedef GAS unsigned gu32;
typedef GAS unsigned long long gu64;
#define RLX_AGENT __ATOMIC_RELAXED, __HIP_MEMORY_SCOPE_AGENT
#define LDS_WAIT() asm volatile("s_waitcnt lgkmcnt(0)" ::: "memory")
#define VM_WAIT() asm volatile("s_waitcnt vmcnt(0)" ::: "memory")
__device__ __forceinline__ unsigned long long rt() { return __builtin_amdgcn_s_memrealtime(); }
__device__ __forceinline__ unsigned f2bf(float f) { unsigned u = __builtin_bit_cast(unsigned, f); return (u + 0x7fffu + ((u >> 16) & 1u)) >> 16; }
__device__ __forceinline__ unsigned pk2(float lo, float hi) { return f2bf(lo) | (f2bf(hi) << 16); }
#define XB_TMO      128
#define XB_XCNT(j)  (256  + 64 * (j))
#define XB_XSUB(j)  (1280 + 64 * (j))
#define XB_XGEN(j)  (2304 + 64 * (j))
#define XB_TOP      3328
#define XB_TOPGEN   3392
#define XCD_BAR_WORDS 3456
#define XB_SPIN_CAP (1u << 18)

__device__ __forceinline__ unsigned xb_ld(unsigned* p)              { return __hip_atomic_load(p, __ATOMIC_RELAXED, __HIP_MEMORY_SCOPE_AGENT); }
__device__ __forceinline__ unsigned xb_add(unsigned* p, unsigned v) { return __hip_atomic_fetch_add(p, v, __ATOMIC_RELAXED, __HIP_MEMORY_SCOPE_AGENT); }
__device__ __forceinline__ unsigned xb_xcc_id() { return (unsigned)__builtin_amdgcn_s_getreg((3 << 11) | 20) & 0xFu; }
#define XB_SPIN(cond, bar) do { unsigned _sp = 0; while (cond) { __builtin_amdgcn_s_sleep(1); \
    if ((++_sp & 255u) == 0u) { if (xb_ld(&(bar)[XB_TMO])) break; if (_sp > XB_SPIN_CAP) { atomicAdd(&(bar)[XB_TMO], 1u); break; } } } } while (0)

struct XcdBarrier {
    unsigned* bar; unsigned x;
    volatile LAS unsigned* st;
};

__device__ __forceinline__ XcdBarrier xcd_barrier_post(unsigned* bar, volatile LAS unsigned* st) {
    XcdBarrier b; b.bar = bar; b.x = xb_xcc_id(); b.st = st;
    if (threadIdx.x == 0) (void)xb_add(&bar[XB_XCNT(b.x)], 1u);
    return b;
}
__device__ __forceinline__ void xcd_barrier_complete(unsigned* bar, unsigned x, unsigned& nloc, unsigned& nx) {
    const unsigned G = gridDim.x * gridDim.y * gridDim.z;
    unsigned sum, cnt, mine, sp = 0u;
    for (;;) {
        sum = 0u; cnt = 0u; mine = 0u;
#pragma unroll
        for (unsigned j = 0; j < 16; ++j) { const unsigned c = xb_ld(&bar[XB_XCNT(j)]); sum += c; cnt += (c > 0u) ? 1u : 0u; mine = (j == x) ? c : mine; }
        if (sum == G) break;
        __builtin_amdgcn_s_sleep(1);
        if ((++sp & 255u) == 0u) { if (xb_ld(&bar[XB_TMO])) break; if (sp > XB_SPIN_CAP) { atomicAdd(&bar[XB_TMO], 1u); break; } }
    }
    nloc = mine > 0u ? mine : 1u; nx = cnt > 0u ? cnt : 1u;
}

__device__ __forceinline__ void xcd_barrier(const XcdBarrier& b) {
    asm volatile("s_waitcnt vmcnt(0)" ::: "memory");
    __syncthreads();
    if (threadIdx.x == 0) {
        unsigned* bar = b.bar;
        __builtin_amdgcn_s_waitcnt(0);
        unsigned nloc = b.st[0], nx = b.st[1];
        if (nloc == 0u) { xcd_barrier_complete(bar, b.x, nloc, nx); b.st[0] = nloc; b.st[1] = nx; }
        const unsigned old = xb_add(&bar[XB_XSUB(b.x)], 1u);
        const unsigned gen = old / nloc;
        if (old + 1u == (gen + 1u) * nloc) {
            __builtin_amdgcn_fence(__ATOMIC_RELEASE, "agent");
            asm volatile("s_waitcnt vmcnt(0)" ::: "memory");
            const unsigned og = xb_add(&bar[XB_TOP], 1u);
            const unsigned tg = og / nx;
            if (og + 1u == (tg + 1u) * nx) xb_add(&bar[XB_TOPGEN], 1u);
            else XB_SPIN(xb_ld(&bar[XB_TOPGEN]) == tg, bar);
            __builtin_amdgcn_fence(__ATOMIC_ACQUIRE, "agent");
            xb_add(&bar[XB_XGEN(b.x)], 1u);
            asm volatile("s_waitcnt vmcnt(0)" ::: "memory");
        } else {
            XB_SPIN(xb_ld(&bar[XB_XGEN(b.x)]) == gen, bar);
            __builtin_amdgcn_fence(__ATOMIC_ACQUIRE, "agent");
            asm volatile("s_waitcnt vmcnt(0)" ::: "memory");
        }
    }
    __syncthreads();
}

constexpr int NWAVES = 8;
#ifndef MK_N_LAUNCHES
#define MK_N_LAUNCHES 1
#endif
constexpr int N_PHASES = 9;
constexpr int N_LAUNCHES = MK_N_LAUNCHES;
constexpr int BATCH = 32, SEQ = 2048, D = 1024, FF = 4096, M = BATCH * SEQ;
constexpr int NPROJ = 3328;
constexpr int W_IN_LD = 3088, ADA_LD = 6 * D;
constexpr float EPS = 1e-6f, LOG2E = 1.4426950408889634f;

constexpr size_t MiB = 1u << 20;
constexpr size_t WS_CTL = 0, CTL_ZERO_BYTES = 1 * MiB;
constexpr size_t WS_ADA = 1 * MiB;
constexpr size_t WS_WIN = 2 * MiB, WS_WOUT = 9 * MiB, WS_W1 = 11 * MiB, WS_W2 = 19 * MiB;
constexpr size_t WS_XN = 32 * MiB;
constexpr size_t WS_G4 = 160 * MiB;
constexpr size_t WS_QM = 352 * MiB, WS_KM = 416 * MiB, WS_VM = 480 * MiB;
constexpr size_t WS_LOGA = 544 * MiB;
constexpr size_t WS_U = 160 * MiB;
constexpr size_t WS_MIX = 736 * MiB;
constexpr size_t WS_END = 864 * MiB;
static_assert(WS_U + (size_t)M * FF * 2 <= WS_MIX && WS_LOGA + (size_t)M * 256 * 4 <= WS_MIX && WS_W2 + (size_t)D * FF * 2 <= WS_XN, "d_ws map");
constexpr int CW_TMO = 0, CW_CODE = 1, CW_BAR = 4096;

constexpr int RING_OFF = 0, RING_BYTES = 139264;
constexpr int LDSCTL_OFF = RING_BYTES, MISC_OFF = LDSCTL_OFF + 320;
constexpr int LDS_BYTES = 147456;
static_assert(MISC_OFF + 128 <= LDS_BYTES, "LDS map");

struct Frame {
    LAS unsigned char* lds;
    volatile LAS unsigned* MISC;
    gu32* ctl;
    int tid, lane, wave;
    int vcu, G;
};

__device__ __forceinline__ float wave_sum(float v) {
#pragma unroll
    for (int o = 1; o < 64; o <<= 1) v += __shfl_xor(v, o);
    return v;
}
__device__ __forceinline__ float bf2f(unsigned short u) { return __uint_as_float((unsigned)u << 16); }
typedef float f32x2_t __attribute__((ext_vector_type(2))); typedef __bf16 bf16x2_t __attribute__((ext_vector_type(2)));
__device__ __forceinline__ unsigned cvtpk_s(float lo, float hi) { f32x2_t v = {lo, hi}; bf16x2_t b = __builtin_convertvector(v, bf16x2_t); return __builtin_bit_cast(unsigned, b); }
__device__ __forceinline__ unsigned short f2bf_s(float f) { return (unsigned short)(cvtpk_s(f, 0.f) & 0xffffu); }
typedef float f32x16 __attribute__((ext_vector_type(16)));
typedef short s16x4 __attribute__((ext_vector_type(4)));
typedef short v4i16_t __attribute__((ext_vector_type(4)));
#define MFMA32(a, b, c) __builtin_amdgcn_mfma_f32_32x32x16_bf16((a), (b), (c), 0, 0, 0)
__device__ __forceinline__ int crow(int reg, int h) { return (reg & 3) + 8 * (reg >> 2) + 4 * h; }
#define PACK8(x, s) __builtin_bit_cast(bf16x8, (v4u){cvtpk_s((x)[8 * (s)], (x)[8 * (s) + 1]), cvtpk_s((x)[8 * (s) + 2], (x)[8 * (s) + 3]), cvtpk_s((x)[8 * (s) + 4], (x)[8 * (s) + 5]), cvtpk_s((x)[8 * (s) + 6], (x)[8 * (s) + 7])})
__device__ __forceinline__ s16x4 tr_read(const LAS unsigned char* p) { return __builtin_bit_cast(s16x4, __builtin_amdgcn_ds_read_tr16_b64_v4i16((LAS v4i16_t*)p)); }
__device__ __forceinline__ bf16x8 cat8(s16x4 lo, s16x4 hi) { return __builtin_shufflevector(lo, hi, 0, 1, 2, 3, 4, 5, 6, 7); }

__device__ __forceinline__ void transpose_item(const float* W, int ldw, int nblk, bf16* WT, int K, int row_off, LAS float* scr, int item, int lane) {
    const int kb = item / nblk, nb = item % nblk, k0 = 64 * kb, n0 = 32 * nb;
#pragma unroll 8
    for (int i = 0; i < 32; ++i) { const int kk = 2 * i + (lane >> 5); scr[kk * 33 + (lane & 31)] = W[(size_t)(k0 + kk) * ldw + n0 + (lane & 31)]; }
    LDS_WAIT(); asm volatile("" ::: "memory");
    const int c = lane & 7;
#pragma unroll
    for (int j = 0; j < 4; ++j) { const int n = (lane >> 3) + 8 * j; const LAS float* s = scr + (8 * c) * 33 + n;
        v4u o; o.x = pk2(s[0 * 33], s[1 * 33]); o.y = pk2(s[2 * 33], s[3 * 33]); o.z = pk2(s[4 * 33], s[5 * 33]); o.w = pk2(s[6 * 33], s[7 * 33]);
        *(GAS v4u*)(WT + (size_t)(row_off + n0 + n) * K + k0 + 8 * c) = o; }
    LDS_WAIT(); asm volatile("" ::: "memory");
}
struct Ptrs {
    const float *x, *c, *w_ada, *b_ada, *g_mix, *w_in, *w_gate, *b_gate, *g_gla, *rel_bias, *w_out, *g_mlp, *w_ff1, *w_ff2, *g_final;
    float* out; float* ada; float* loga;
    bf16 *Win_t, *Wout_t, *W1_t, *W2_t, *XN, *G4, *QM, *KM, *VM, *U, *MIX;
};
__device__ __forceinline__ void p0_prologue(Frame& F, const Ptrs& P) {
    LAS float* scr = (LAS float*)(F.lds + RING_OFF + F.wave * 16384);
    const int gw = F.vcu * NWAVES + F.wave, NGW = F.G * NWAVES;
    for (int it = F.G - 1 - (int)blockIdx.x; it < ADA_LD / 64; it += F.G) {
        const int n0 = it * 64, kbase = 128 * F.wave;
#pragma unroll 4
        for (int i = 0; i < 64; ++i) { const int b = (F.lane >> 3) + 8 * (i & 3), kk = (F.lane & 7) + 8 * (i >> 2);
            const float cv = P.c[b * D + kbase + kk]; scr[kk * 32 + b] = cv / (1.f + __expf(-cv)); }
        LDS_WAIT(); asm volatile("" ::: "memory");
        float acc[32];
#pragma unroll
        for (int b = 0; b < 32; ++b) acc[b] = 0.f;
#pragma unroll 4
        for (int kk = 0; kk < 128; ++kk) { const float w = P.w_ada[(size_t)(kbase + kk) * ADA_LD + n0 + F.lane];
#pragma unroll
            for (int g = 0; g < 8; ++g) { const f32x4 cv = *(const LAS f32x4*)(scr + kk * 32 + 4 * g);
                acc[4 * g] += cv[0] * w; acc[4 * g + 1] += cv[1] * w; acc[4 * g + 2] += cv[2] * w; acc[4 * g + 3] += cv[3] * w; } }
        __syncthreads();
        LAS float* red = (LAS float*)(F.lds + RING_OFF);
#pragma unroll
        for (int b = 0; b < 32; ++b) red[(F.wave * 32 + b) * 64 + F.lane] = acc[b];
        __syncthreads();
#pragma unroll
        for (int o = 0; o < 4; ++o) { const int idx = F.tid + 512 * o, b = idx >> 6, n = idx & 63; float s = P.b_ada[n0 + n];
#pragma unroll
            for (int w = 0; w < 8; ++w) s += red[(w * 32 + b) * 64 + n];
            P.ada[b * ADA_LD + n0 + n] = s; }
        __syncthreads();
    }
    constexpr int I_IN = (D / 64) * 48, I_OUT = (D / 64) * (D / 32), I_1 = (D / 64) * (FF / 32), I_2 = (FF / 64) * (D / 32), I_G = 16 * 8;
    constexpr int NITEMS = 2 * I_IN + I_OUT + I_1 + I_2 + I_G;
    for (int it = gw; it < NITEMS; it += NGW) {
        int r = it;
        if (r < I_IN) { transpose_item(P.w_in, W_IN_LD, 48, P.Win_t, D, 0, scr, r, F.lane); continue; } r -= I_IN;
        if (r < I_IN) { transpose_item(P.w_in + 1552, W_IN_LD, 48, P.Win_t, D, 1536, scr, r, F.lane); continue; } r -= I_IN;
        if (r < I_OUT) { transpose_item(P.w_out, D, D / 32, P.Wout_t, D, 0, scr, r, F.lane); continue; } r -= I_OUT;
        if (r < I_1) { transpose_item(P.w_ff1, FF, FF / 32, P.W1_t, D, 0, scr, r, F.lane); continue; } r -= I_1;
        if (r < I_2) { transpose_item(P.w_ff2, D, D / 32, P.W2_t, FF, 0, scr, r, F.lane); continue; } r -= I_2;
        { const int kb = r >> 3, jb = r & 7, k = 64 * kb + F.lane; float a[16];
#pragma unroll
          for (int q = 0; q < 4; ++q) { const f32x4 v = *(const f32x4*)(P.w_in + (size_t)k * W_IN_LD + 1536 + 4 * q); a[4 * q] = v[0]; a[4 * q + 1] = v[1]; a[4 * q + 2] = v[2]; a[4 * q + 3] = v[3]; }
          for (int jj = 0; jj < 32; ++jj) { const int j = 32 * jb + jj; float s = 0.f;
#pragma unroll
              for (int q = 0; q < 16; ++q) s += a[q] * P.w_gate[q * 256 + j];
              P.Win_t[(size_t)(3072 + j) * D + k] = (bf16)f2bf(s); } }
    }
}

template <int MODE> __device__ __forceinline__ void norm_phase(Frame& F, const float* src, bf16* dst_bf, float* dst_f, const float* g, const float* ada, int shift_off, int scale_off) {
    const int gw = F.vcu * NWAVES + F.wave, NGW = F.G * NWAVES;
    for (int rb = gw; rb < M / 32; rb += NGW) {
        const int row0 = rb * 32, b = row0 / SEQ;
        f32x4 ca[4], cb[4];
#pragma unroll
        for (int j = 0; j < 4; ++j) { const int col = 4 * F.lane + 256 * j; const f32x4 gg = *(const f32x4*)(g + col);
            if (MODE == 0) { const f32x4 sc = *(const f32x4*)(ada + (size_t)b * ADA_LD + scale_off + col), sh = *(const f32x4*)(ada + (size_t)b * ADA_LD + shift_off + col);
                ca[j] = gg * (1.f + sc); cb[j] = sh; }
            else { ca[j] = gg; cb[j] = (f32x4){0.f, 0.f, 0.f, 0.f}; } }
#pragma unroll 2
        for (int rr = 0; rr < 32; ++rr) { const size_t row = (size_t)(row0 + rr);
            const GAS f32x4* xr = (const GAS f32x4*)(src + row * D) + F.lane;
            f32x4 v[4]; float s = 0.f;
#pragma unroll
            for (int j = 0; j < 4; ++j) { v[j] = xr[64 * j]; s += (v[j].x * v[j].x + v[j].y * v[j].y) + (v[j].z * v[j].z + v[j].w * v[j].w); }
            const float rstd = 1.f / sqrtf(wave_sum(s) * (1.f / D) + EPS);
            if (MODE == 0) { GAS unsigned long long* o8 = (GAS unsigned long long*)(dst_bf + row * D) + F.lane;
#pragma unroll
                for (int j = 0; j < 4; ++j) { const f32x4 y = v[j] * rstd * ca[j] + cb[j];
                    o8[64 * j] = (unsigned long long)cvtpk_s(y.x, y.y) | ((unsigned long long)cvtpk_s(y.z, y.w) << 32); } }
            else { GAS f32x4* o = (GAS f32x4*)(dst_f + row * D) + F.lane;
#pragma unroll
                for (int j = 0; j < 4; ++j) o[64 * j] = v[j] * rstd * ca[j]; }
        }
    }
}

constexpr int GST = 144;
constexpr int GOST = 528;
constexpr int GL_QT = 0, GL_KT = 9216, GL_V = 18432, GL_GRAW = GL_V + 2 * 16384, GL_QRAW = GL_GRAW + 16384, GL_KRAW = GL_QRAW + 8192, GL_GRRAW = GL_KRAW + 8192, GL_OST = GL_GRRAW + 16384,
              GL_VEC = GL_OST + 64 * GOST, GL_TOT = GL_VEC + 2 * 768, GL_SSQ = GL_TOT + 1024, GL_GOUT = GL_SSQ + 1024, GL_END = GL_GOUT + 512;
static_assert(GL_END <= RING_BYTES, "GLA LDS map");
#define GLA_BAR() do { asm volatile("s_waitcnt lgkmcnt(0)" ::: "memory"); __builtin_amdgcn_s_barrier(); asm volatile("" ::: "memory"); } while (0)
#define GLA_VMWAIT(n) asm volatile("s_waitcnt vmcnt(" #n ")" ::: "memory")
#define GLA_DMA(gsrc, ldsdst) __builtin_amdgcn_global_load_lds((const unsigned*)(gsrc), (LAS unsigned*)(ldsdst), 16, 0, 0)
__device__ __forceinline__ void gla_task(Frame& F, const Ptrs& P, int task) {
    const int b = task >> 2, h = task & 3;
    LAS unsigned char* L = F.lds + RING_OFF;
    const int w = F.wave, lane = F.lane, r = lane & 31, hh = lane >> 5;
    const bool producer = w >= 4; const int pw = w - 4, ptid = F.tid - 256;
    LAS float* TOT = (LAS float*)(L + GL_TOT); LAS float* GOUT = (LAS float*)(L + GL_GOUT);
    const int q4 = (lane & 15) >> 2, p4 = lane & 3, blk = (lane >> 4) & 1;
    const size_t tb = (size_t)b * SEQ;
    constexpr int NC = SEQ / 64;
    if (producer) {
        const float* gsrc = P.loga + (tb + 16 * pw + (lane >> 4)) * 256 + h * 64 + (lane & 15) * 4;
        const bf16* qsrc = P.G4 + (tb + 16 * pw + (lane >> 3)) * 1536 + h * 64 + (lane & 7) * 8;
        const bf16* vsrc = P.G4 + (tb + 16 * pw + (lane >> 4)) * 1536 + 512 + h * 128 + (((lane & 15) ^ (4 * (lane >> 4))) * 8);
        const bf16* rsrc = P.G4 + (tb + 16 * pw + (lane >> 4)) * 1536 + 1024 + h * 128 + (lane & 15) * 8;
#define GLA_DMA_G(cc) do { _Pragma("unroll") for (int j = 0; j < 4; ++j) GLA_DMA(gsrc + ((size_t)(cc) * 64 + 4 * j) * 256, L + GL_GRAW + (16 * pw + 4 * j) * 256); } while (0)
#define GLA_DMA_QKV(cc) do { _Pragma("unroll") for (int j = 0; j < 2; ++j) GLA_DMA(qsrc + ((size_t)(cc) * 64 + 8 * j) * 1536, L + GL_QRAW + (16 * pw + 8 * j) * 128); \
        _Pragma("unroll") for (int j = 0; j < 2; ++j) GLA_DMA(qsrc + 256 + ((size_t)(cc) * 64 + 8 * j) * 1536, L + GL_KRAW + (16 * pw + 8 * j) * 128); \
        _Pragma("unroll") for (int j = 0; j < 4; ++j) GLA_DMA(vsrc + ((size_t)(cc) * 64 + 4 * j) * 1536, L + GL_V + ((cc) & 1) * 16384 + (4 * pw + j) * 1024); } while (0)
#define GLA_DMA_GR(cc) do { _Pragma("unroll") for (int j = 0; j < 4; ++j) GLA_DMA(rsrc + ((size_t)(cc) * 64 + 4 * j) * 1536, L + GL_GRRAW + (16 * pw + 4 * j) * 256); } while (0)
        const int otok = ptid >> 2, ocg = ptid & 3;
        float cs[16];
        GLA_DMA_G(0); GLA_DMA_QKV(0);
        if (ptid < 128) GOUT[ptid] = P.g_gla[h * 128 + ptid];
        for (int c = -1; c <= NC; ++c) {
            const bool steady = (c >= 2) && (c + 3 < NC);
            const int bn = (c + 1) & 1;
            if (c + 1 < NC) {
                if (steady) GLA_VMWAIT(16); else GLA_VMWAIT(0);
                float run = 0.f;
#pragma unroll
                for (int i = 0; i < 16; ++i) { run += *(const LAS float*)(L + GL_GRAW + (16 * pw + i) * 256 + lane * 4); cs[i] = run; }
                TOT[pw * 64 + lane] = run;
                asm volatile("s_waitcnt lgkmcnt(0)" ::: "memory");
                if (c + 2 < NC) GLA_DMA_G(c + 2);
            }
            if (c >= 1) {
                if (steady) GLA_VMWAIT(12); else GLA_VMWAIT(0);
                const size_t t0 = tb + (size_t)(c - 1) * 64;
                f32x4 ov_[8]; float ss = 0.f;
#pragma unroll
                for (int k = 0; k < 8; ++k) { ov_[k] = *(const LAS f32x4*)(L + GL_OST + otok * GOST + (ocg * 32 + 4 * k) * 4); ss += (ov_[k][0] * ov_[k][0] + ov_[k][1] * ov_[k][1]) + (ov_[k][2] * ov_[k][2] + ov_[k][3] * ov_[k][3]); }
                ss += __shfl_xor(ss, 1); ss += __shfl_xor(ss, 2);
                const float rstd = __builtin_amdgcn_rsqf(ss * (1.f / 128.f) + EPS);
#pragma unroll
                for (int k = 0; k < 4; ++k) { const f32x4 a0 = ov_[2 * k], a1 = ov_[2 * k + 1];
                    const f32x4 g0 = *(const LAS f32x4*)(GOUT + ocg * 32 + 8 * k), g1 = *(const LAS f32x4*)(GOUT + ocg * 32 + 8 * k + 4);
                    const v4u gw = *(const LAS v4u*)(L + GL_GRRAW + otok * 256 + ocg * 64 + 16 * k); float gr[8];
                    gr[0] = __uint_as_float(gw.x << 16); gr[1] = __uint_as_float(gw.x & 0xffff0000u); gr[2] = __uint_as_float(gw.y << 16); gr[3] = __uint_as_float(gw.y & 0xffff0000u);
                    gr[4] = __uint_as_float(gw.z << 16); gr[5] = __uint_as_float(gw.z & 0xffff0000u); gr[6] = __uint_as_float(gw.w << 16); gr[7] = __uint_as_float(gw.w & 0xffff0000u);
                    float y[8];
#pragma unroll
                    for (int e = 0; e < 4; ++e) { y[e] = a0[e] * rstd * g0[e] * (gr[e] * __builtin_amdgcn_rcpf(1.f + __expf(-gr[e]))); y[4 + e] = a1[e] * rstd * g1[e] * (gr[4 + e] * __builtin_amdgcn_rcpf(1.f + __expf(-gr[4 + e]))); }
                    v4u ov; ov.x = cvtpk_s(y[0], y[1]); ov.y = cvtpk_s(y[2], y[3]); ov.z = cvtpk_s(y[4], y[5]); ov.w = cvtpk_s(y[6], y[7]);
                    *(v4u*)(P.MIX + (t0 + otok) * 1024 + h * 128 + ocg * 32 + 8 * k) = ov; }
            }
            if (c >= 0 && c < NC) { asm volatile("s_waitcnt lgkmcnt(0)" ::: "memory"); GLA_DMA_GR(c); }
            GLA_BAR();
            if (c + 1 < NC) {
                if (steady) GLA_VMWAIT(12); else GLA_VMWAIT(0);
                float off = 0.f, bref = 0.f, blast = 0.f;
#pragma unroll
                for (int ww = 0; ww < 4; ++ww) { const float t = TOT[ww * 64 + lane]; off += (ww < pw) ? t : 0.f; bref += (ww < 2) ? t : 0.f; blast += t; }
                LAS float* VECn = (LAS float*)(L + GL_VEC + bn * 768);
#pragma unroll
                for (int i = 0; i < 16; ++i) { const float bi_ = cs[i] + off; const float E = __expf(bi_ - bref), Ei = __expf(bref - bi_);
                    const unsigned short qv = *(const LAS unsigned short*)(L + GL_QRAW + (16 * pw + i) * 128 + 2 * lane), kv = *(const LAS unsigned short*)(L + GL_KRAW + (16 * pw + i) * 128 + 2 * lane);
                    *(LAS unsigned short*)(L + GL_QT + (16 * pw + i) * GST + 2 * lane) = f2bf_s(bf2f(qv) * 0.125f * E); *(LAS unsigned short*)(L + GL_KT + (16 * pw + i) * GST + 2 * lane) = f2bf_s(bf2f(kv) * Ei); }
                if (pw == 0) { VECn[lane] = __expf(bref); VECn[64 + lane] = __expf(blast); VECn[128 + lane] = __expf(blast - bref); }
                asm volatile("s_waitcnt lgkmcnt(0)" ::: "memory");
                if (c + 2 < NC) GLA_DMA_QKV(c + 2);
            } else { GLA_VMWAIT(0); }
            GLA_BAR();
        }
        GLA_VMWAIT(0);
#undef GLA_DMA_G
#undef GLA_DMA_QKV
#undef GLA_DMA_GR
    } else {
        f32x16 S0, S1, o0, o1, kv0, kv1;
#pragma unroll
        for (int i = 0; i < 16; ++i) { S0[i] = 0.f; S1[i] = 0.f; o0[i] = 0.f; o1[i] = 0.f; kv0[i] = 0.f; kv1[i] = 0.f; }
        const int vlane = q4 * 256 + (((4 * w + 2 * blk + (p4 >> 1)) ^ (4 * q4)) * 16) + 8 * (p4 & 1);
        const int kcb = 2 * (16 * blk + 4 * p4);
        for (int c = -1; c <= NC; ++c) {
            const bool cur = (c >= 0) && (c < NC);
            const int bi = c & 1;
            if (cur) {
                const LAS unsigned char* QT = L + GL_QT; const LAS unsigned char* KT = L + GL_KT; const LAS unsigned char* VI = L + GL_V + bi * 16384 + vlane; const LAS float* VEC = (const LAS float*)(L + GL_VEC + bi * 768);
                f32x16 X00, X01, X11;
#pragma unroll
                for (int i = 0; i < 16; ++i) { X00[i] = 0.f; X01[i] = 0.f; X11[i] = 0.f; o0[i] = 0.f; o1[i] = 0.f; kv0[i] = 0.f; kv1[i] = 0.f; }
#define GLA_SB() __builtin_amdgcn_sched_barrier(0)
                bf16x8 kf0[4], kf1[4], qf0[4], qf1[4];
#pragma unroll
                for (int d0 = 0; d0 < 4; ++d0) { kf0[d0] = *(const LAS bf16x8*)(KT + r * GST + 32 * d0 + 16 * hh); kf1[d0] = *(const LAS bf16x8*)(KT + (32 + r) * GST + 32 * d0 + 16 * hh);
                    qf0[d0] = *(const LAS bf16x8*)(QT + r * GST + 32 * d0 + 16 * hh); qf1[d0] = *(const LAS bf16x8*)(QT + (32 + r) * GST + 32 * d0 + 16 * hh); }
                GLA_SB();
                s16x4 vi[2][2][2];
#pragma unroll
                for (int s = 0; s < 2; ++s) { vi[0][s][0] = tr_read(VI + (4 * s + hh) * 1024); vi[0][s][1] = tr_read(VI + (4 * s + hh + 2) * 1024); vi[1][s][0] = tr_read(VI + (8 + 4 * s + hh) * 1024); vi[1][s][1] = tr_read(VI + (8 + 4 * s + hh + 2) * 1024); }
                GLA_SB();
#pragma unroll
                for (int d0 = 0; d0 < 4; ++d0) { X00 = MFMA32(kf0[d0], qf0[d0], X00); X01 = MFMA32(kf0[d0], qf1[d0], X01); X11 = MFMA32(kf1[d0], qf1[d0], X11); }
                GLA_SB();
                const LAS unsigned char* q0row = QT + r * GST; const LAS unsigned char* q1row = QT + (32 + r) * GST;
                s16x4 qa[2][2][2][2];
#pragma unroll
                for (int s = 0; s < 2; ++s)
#pragma unroll
                    for (int dt = 0; dt < 2; ++dt) { qa[0][dt][s][0] = *(const LAS s16x4*)(q0row + 2 * (32 * dt + 16 * s + 4 * hh)); qa[0][dt][s][1] = *(const LAS s16x4*)(q0row + 2 * (32 * dt + 16 * s + 8 + 4 * hh));
                        qa[1][dt][s][0] = *(const LAS s16x4*)(q1row + 2 * (32 * dt + 16 * s + 4 * hh)); qa[1][dt][s][1] = *(const LAS s16x4*)(q1row + 2 * (32 * dt + 16 * s + 8 + 4 * hh)); }
                f32x4 eb0[4], eb1[4];
#pragma unroll
                for (int g = 0; g < 4; ++g) { eb0[g] = *(const LAS f32x4*)(VEC + 8 * g + 4 * hh); eb1[g] = *(const LAS f32x4*)(VEC + 32 + 8 * g + 4 * hh); }
                GLA_SB();
#pragma unroll
                for (int i = 0; i < 16; ++i) { const bool keep = crow(i, hh) <= r; X00[i] = keep ? X00[i] : 0.f; X11[i] = keep ? X11[i] : 0.f; }
#pragma unroll
                for (int s = 0; s < 2; ++s) { const bf16x8 v0f = cat8(vi[0][s][0], vi[0][s][1]), v1f = cat8(vi[1][s][0], vi[1][s][1]);
                    o0 = MFMA32(PACK8(X00, s), v0f, o0); o1 = MFMA32(PACK8(X01, s), v0f, o1); o1 = MFMA32(PACK8(X11, s), v1f, o1); }
                GLA_SB();
                s16x4 kvv[4][2], kva[4][2], kvb[4][2];
#pragma unroll
                for (int tt = 0; tt < 2; ++tt) { const int trow = 16 * tt + 8 * hh + q4;
                    kvv[tt][0] = tr_read(VI + (4 * tt + 2 * hh) * 1024); kvv[tt][1] = tr_read(VI + (4 * tt + 2 * hh + 1) * 1024);
                    kva[tt][0] = tr_read(KT + trow * GST + kcb); kva[tt][1] = tr_read(KT + (trow + 4) * GST + kcb);
                    kvb[tt][0] = tr_read(KT + trow * GST + kcb + 64); kvb[tt][1] = tr_read(KT + (trow + 4) * GST + kcb + 64); }
                GLA_SB();
                { f32x16 T0, T1;
#pragma unroll
                  for (int g = 0; g < 4; ++g)
#pragma unroll
                      for (int e = 0; e < 4; ++e) { T0[4 * g + e] = S0[4 * g + e] * eb0[g][e]; T1[4 * g + e] = S1[4 * g + e] * eb1[g][e]; }
#pragma unroll
                  for (int s = 0; s < 2; ++s) { const bf16x8 sb0 = PACK8(T0, s), sb1 = PACK8(T1, s);
                      o0 = MFMA32(cat8(qa[0][0][s][0], qa[0][0][s][1]), sb0, o0); o0 = MFMA32(cat8(qa[0][1][s][0], qa[0][1][s][1]), sb1, o0);
                      o1 = MFMA32(cat8(qa[1][0][s][0], qa[1][0][s][1]), sb0, o1); o1 = MFMA32(cat8(qa[1][1][s][0], qa[1][1][s][1]), sb1, o1); } }
                GLA_SB();
#pragma unroll
                for (int tt = 2; tt < 4; ++tt) { const int trow = 16 * tt + 8 * hh + q4;
                    kvv[tt][0] = tr_read(VI + (4 * tt + 2 * hh) * 1024); kvv[tt][1] = tr_read(VI + (4 * tt + 2 * hh + 1) * 1024);
                    kva[tt][0] = tr_read(KT + trow * GST + kcb); kva[tt][1] = tr_read(KT + (trow + 4) * GST + kcb);
                    kvb[tt][0] = tr_read(KT + trow * GST + kcb + 64); kvb[tt][1] = tr_read(KT + (trow + 4) * GST + kcb + 64); }
                GLA_SB();
#pragma unroll
                for (int tt = 0; tt < 4; ++tt) { const bf16x8 vb = cat8(kvv[tt][0], kvv[tt][1]);
                    kv0 = MFMA32(cat8(kva[tt][0], kva[tt][1]), vb, kv0); kv1 = MFMA32(cat8(kvb[tt][0], kvb[tt][1]), vb, kv1); }
#undef GLA_SB
            }
            GLA_BAR();
            if (cur) {
                const LAS float* VEC = (const LAS float*)(L + GL_VEC + bi * 768);
#pragma unroll
                for (int g = 0; g < 4; ++g) { const f32x4 dc0 = *(const LAS f32x4*)(VEC + 64 + 8 * g + 4 * hh), dc1 = *(const LAS f32x4*)(VEC + 64 + 32 + 8 * g + 4 * hh);
                    const f32x4 d10 = *(const LAS f32x4*)(VEC + 128 + 8 * g + 4 * hh), d11 = *(const LAS f32x4*)(VEC + 128 + 32 + 8 * g + 4 * hh);
#pragma unroll
                    for (int e = 0; e < 4; ++e) { S0[4 * g + e] = dc0[e] * S0[4 * g + e] + d10[e] * kv0[4 * g + e]; S1[4 * g + e] = dc1[e] * S1[4 * g + e] + d11[e] * kv1[4 * g + e]; } }
#pragma unroll
                for (int i = 0; i < 16; ++i) { *(LAS float*)(L + GL_OST + crow(i, hh) * GOST + (32 * w + r) * 4) = o0[i]; *(LAS float*)(L + GL_OST + (32 + crow(i, hh)) * GOST + (32 * w + r) * 4) = o1[i]; }
            }
            GLA_BAR();
        }
    }
    __syncthreads();
}

namespace attn_body {
using bf16=__hip_bfloat16;
using bf16x8=__attribute__((ext_vector_type(8)))short;
using s16x4=__attribute__((ext_vector_type(4)))short;
using f32x16=__attribute__((ext_vector_type(16)))float;
using u32x4=__attribute__((ext_vector_type(4)))unsigned;
constexpr int SEQ=2048,D=64,QP=512,OP=1024;
constexpr int NW=8,QBLK=32,QB=QBLK*NW,KVBLK=64,NQB=SEQ/QB;
__device__ __forceinline__ int crow(int r,int hi){return (r&3)+8*(r>>2)+4*hi;}
#define SBAR() __builtin_amdgcn_sched_barrier(0)
typedef __attribute__((address_space(3))) const float* lds_cfptr;
typedef float f32x4_t __attribute__((ext_vector_type(4)));
constexpr int NB_OFF=256, NB_N=648, NB_ROWB=NB_N*4;
__device__ __forceinline__ void nmask(f32x16&p0,f32x16&p1,int kb,int qabs,int hi,lds_cfptr tab){
  const int base=qabs-kb-4*hi-3+NB_OFF; const int s=base&3, al=base&~3;
  const __attribute__((address_space(3))) char* tp=(const __attribute__((address_space(3))) char*)tab+s*NB_ROWB+al*4;
  #pragma unroll
  for(int g=0;g<4;++g){
    const f32x4_t v0=*(const __attribute__((address_space(3))) f32x4_t*)(tp-32*g), v1=*(const __attribute__((address_space(3))) f32x4_t*)(tp-32*g-128);
    #pragma unroll
    for(int e=0;e<4;++e){p0[4*g+e]+=v0[3-e]; p1[4*g+e]+=v1[3-e];} }
}
constexpr int NSLOT=3, SLOTB=8192;
constexpr int LDS_K=0, LDS_V=NSLOT*SLOTB, LDS_WS=2*NSLOT*SLOTB, LDS_OST=LDS_WS+NW*64*4, LDS_BYTES=LDS_OST+NW*4096;
constexpr float C2=0.125f*1.4426950408889634f;
__device__ __forceinline__ void glds16(const void*gsrc,unsigned lds_dst){unsigned keep;
  asm volatile("s_mov_b32 %0, m0\n\ts_mov_b32 m0, %2\n\ts_nop 0\n\tglobal_load_lds_dwordx4 %1, off\n\ts_mov_b32 m0, %0":"=&s"(keep):"v"(gsrc),"s"(lds_dst):"memory");}
__device__ __forceinline__ float max3f(float a,float b,float c){float r;asm("v_max3_f32 %0, %1, %2, %3":"=v"(r):"v"(a),"v"(b),"v"(c));return r;}
__device__ __forceinline__ float max2f(float a,float b){float r;asm("v_max_f32_e32 %0, %1, %2":"=v"(r):"v"(a),"v"(b));return r;}
__device__ __forceinline__ float fadd_s(float a,float b){float r;asm("v_add_f32_e32 %0, %1, %2":"=v"(r):"v"(a),"v"(b));return r;}
__device__ __forceinline__ float fsub_s(float a,float b){float r;asm("v_sub_f32_e32 %0, %1, %2":"=v"(r):"v"(a),"v"(b));return r;}
typedef float f32x2_t __attribute__((ext_vector_type(2))); typedef __bf16 bf16x2_t __attribute__((ext_vector_type(2)));
__device__ __forceinline__ unsigned cvtpk_s(float lo,float hi){f32x2_t v={lo,hi};bf16x2_t b=__builtin_convertvector(v,bf16x2_t);return __builtin_bit_cast(unsigned,b);}
#define WAIT_BAR(N) asm volatile("s_waitcnt vmcnt(" #N ") lgkmcnt(0)\n\ts_barrier":::"memory")

__device__ __forceinline__ void qkt(f32x16&p0,f32x16&p1,const char*Kslot,const bf16x8*qr,const f32x16&negm,int r32,int hi){
  const char*kb=Kslot+hi*1024+r32*16;
  #pragma unroll
  for(int d0=0;d0<4;++d0){
    const bf16x8 b0=*reinterpret_cast<const bf16x8*>(kb+d0*2048);
    const bf16x8 b1=*reinterpret_cast<const bf16x8*>(kb+d0*2048+512);
    if(d0==0){p0=__builtin_amdgcn_mfma_f32_32x32x16_bf16(b0,qr[0],negm,0,0,0);p1=__builtin_amdgcn_mfma_f32_32x32x16_bf16(b1,qr[0],negm,0,0,0);}
    else{p0=__builtin_amdgcn_mfma_f32_32x32x16_bf16(b0,qr[d0],p0,0,0,0);p1=__builtin_amdgcn_mfma_f32_32x32x16_bf16(b1,qr[d0],p1,0,0,0);}}
}
typedef __attribute__((address_space(3))) const char* lds_cptr;
typedef short v4i16_t __attribute__((ext_vector_type(4)));
__device__ __forceinline__ void kload8(bf16x8*kf,lds_cptr kp){
  kf[0]=*(const __attribute__((address_space(3))) bf16x8*)(kp);      kf[1]=*(const __attribute__((address_space(3))) bf16x8*)(kp+512);
  kf[2]=*(const __attribute__((address_space(3))) bf16x8*)(kp+2048); kf[3]=*(const __attribute__((address_space(3))) bf16x8*)(kp+2560);
  kf[4]=*(const __attribute__((address_space(3))) bf16x8*)(kp+4096); kf[5]=*(const __attribute__((address_space(3))) bf16x8*)(kp+4608);
  kf[6]=*(const __attribute__((address_space(3))) bf16x8*)(kp+6144); kf[7]=*(const __attribute__((address_space(3))) bf16x8*)(kp+6656);
}
__device__ __forceinline__ void kload2(bf16x8*kf,lds_cptr kp,int j){ kf[2*j]=*(const __attribute__((address_space(3))) bf16x8*)(kp+j*2048); kf[2*j+1]=*(const __attribute__((address_space(3))) bf16x8*)(kp+j*2048+512); }
__device__ __forceinline__ s16x4 vtr(lds_cptr p){ return __builtin_bit_cast(s16x4,__builtin_amdgcn_ds_read_tr16_b64_v4i16((__attribute__((address_space(3))) v4i16_t*)p)); }
__device__ __forceinline__ float rowmax(const f32x16&p0,const f32x16&p1){
  float a=max3f(p0[0],p0[1],p1[0]),b=max3f(p0[2],p0[3],p1[1]);a=max3f(a,p1[2],p1[3]);
  #pragma unroll
  for(int r=4;r<16;r+=4){a=max3f(a,p0[r],p0[r+1]);b=max3f(b,p0[r+2],p0[r+3]);a=max3f(a,p1[r],p1[r+1]);b=max3f(b,p1[r+2],p1[r+3]);}
  const float m=max2f(a,b);
  auto rr=__builtin_amdgcn_permlane32_swap(__float_as_uint(m),__float_as_uint(m),false,false);
  return max2f(__uint_as_float(rr[0]),__uint_as_float(rr[1]));
}
__device__ __forceinline__ void pv(f32x16*o,int vb,bf16x8 pa0,bf16x8 pa1,bf16x8 pa2,bf16x8 pa3){
  #pragma unroll
  for(int d0=0;d0<2;++d0){s16x4 lo[4],hi[4];
    #pragma unroll
    for(int ks=0;ks<4;++ks){
      asm volatile("ds_read_b64_tr_b16 %0,%1 offset:%c2":"=&v"(lo[ks]):"v"(vb),"i"(d0*4096+ks*1024):"memory");
      asm volatile("ds_read_b64_tr_b16 %0,%1 offset:%c2":"=&v"(hi[ks]):"v"(vb),"i"(d0*4096+ks*1024+512):"memory");}
    asm volatile("s_waitcnt lgkmcnt(0)":::"memory");SBAR();
    #define PK(k) (bf16x8){lo[k][0],lo[k][1],lo[k][2],lo[k][3],hi[k][0],hi[k][1],hi[k][2],hi[k][3]}
    o[d0]=__builtin_amdgcn_mfma_f32_32x32x16_bf16(pa0,PK(0),o[d0],0,0,0);
    o[d0]=__builtin_amdgcn_mfma_f32_32x32x16_bf16(pa1,PK(1),o[d0],0,0,0);
    o[d0]=__builtin_amdgcn_mfma_f32_32x32x16_bf16(pa2,PK(2),o[d0],0,0,0);
    o[d0]=__builtin_amdgcn_mfma_f32_32x32x16_bf16(pa3,PK(3),o[d0],0,0,0);
    #undef PK
  }
}

#ifndef ATTN_STORE16
#define ATTN_STORE16(p,v) (*(u32x4*)(p)=(v))
#endif
template<int THRL> __device__ __forceinline__ void attn_unit(const int tid,int b,int h,int qb,const bf16*Q,const bf16*__restrict__ K,const bf16*__restrict__ V,bf16*O,char*shm,lds_cfptr kml,lds_cfptr tab,const float b31){
  const int lane=tid&63,r32=lane&31,hi=lane>>5; const int wid=__builtin_amdgcn_readfirstlane(tid>>6);
  const long rowbase=(long)b*SEQ; const int q0=qb*QB;
  const bf16*Qw=Q+(rowbase+q0+wid*QBLK)*QP+h*D;
  const bf16*Kh=K+rowbase*QP+h*D,*Vh=V+rowbase*QP+h*D;
  const unsigned lds0=(unsigned)(uintptr_t)shm;
  float*wsf=(float*)(shm+LDS_WS)+wid*64;
  const bf16*ksrc=Kh+(long)lane*QP+wid*8;
  const bf16*vsrc=Vh+(long)(16*(wid&3)+(lane>>2))*QP+(wid>>2)*32+(lane&3)*8;
  const unsigned kdst=lds0+LDS_K+wid*1024, vdst=lds0+LDS_V+wid*1024;
  #define DMA_K(t,slot) glds16(ksrc+(long)(t)*KVBLK*QP,(unsigned)__builtin_amdgcn_readfirstlane(kdst+(slot)))
  #define DMA_V(t,slot) glds16(vsrc+(long)(t)*KVBLK*QP,(unsigned)__builtin_amdgcn_readfirstlane(vdst+(slot)))
  const int vb0=(int)(lds0+LDS_V)+((lane>>4)&1)*32+(lane&3)*8+(4*hi+((lane&15)>>2))*64;
  const char*Kbase=shm+LDS_K; bf16x8 kf[8];
  const lds_cptr shm3=(lds_cptr)shm; const lds_cptr kp0=shm3+LDS_K+hi*1024+r32*16; const lds_cptr vp0=shm3+LDS_V+((lane>>4)&1)*32+(lane&3)*8+(4*hi+((lane&15)>>2))*64;
  const int NT=(q0+QB)/KVBLK;
  DMA_K(0,0);DMA_V(0,0);DMA_K(1,SLOTB);
  bf16x8 qr[4];
  #pragma unroll
  for(int d0=0;d0<4;++d0)qr[d0]=*reinterpret_cast<const bf16x8*>(&Qw[(long)r32*QP+d0*16+hi*8]);
  unsigned sel=1u<<qb;
  { float gt[8];
    #pragma unroll
    for(int j=0;j<8;++j){float sg=0.f;
      #pragma unroll
      for(int d0=0;d0<4;++d0){
        #pragma unroll
        for(int e=0;e<8;++e)sg+=__uint_as_float(((unsigned)(unsigned short)qr[d0][e])<<16)*kml[j*64+16*d0+8*hi+e];}
      gt[j]=sg+__shfl_xor(sg,32);}
    #pragma unroll
    for(int j=0;j<8;++j){int rank=0;
      #pragma unroll
      for(int j2=0;j2<8;++j2)if(j2!=j)rank+=(j2<qb&&(gt[j2]>gt[j]||(gt[j2]==gt[j]&&j2<j)))?1:0;
      if(j<qb&&rank<3)sel|=1u<<j;} }
  float mhat=0.f,l_reg=0.f;f32x16 o[2];o[0]=f32x16{};o[1]=f32x16{};f32x16 negm=f32x16{};asm volatile("":"+v"(negm));
  const int qabs=q0+wid*QBLK+r32;
  #define CMASK(P0,P1,t) do{ if((t)>=NT-6)nmask(P0,P1,64*(t),qabs,hi,tab); }while(0)
  #define NEGM(t) do{ const float nv_=((sel>>((t)>>2))&1u)?((((t)<NT-6)?b31:0.f)-mhat):-INFINITY; _Pragma("unroll") for(int r=0;r<16;++r)negm[r]=nv_; asm volatile("":"+v"(negm)); }while(0)
  bool resc=false;
  #define START(P0,P1) do{ const float rm=rowmax(P0,P1); resc=false; \
    { const float dl=__builtin_fmaxf(rm,0.f); mhat=fadd_s(mhat,dl); \
      _Pragma("unroll") for(int r=0;r<16;++r){P0[r]=fsub_s(P0[r],dl);P1[r]=fsub_s(P1[r],dl);} } \
    _Pragma("unroll") for(int r=0;r<16;++r)P0[r]=__builtin_amdgcn_exp2f(P0[r]); }while(0)
  #define RESC() do{ if(resc){ asm volatile("s_waitcnt lgkmcnt(0)":::"memory"); \
      _Pragma("unroll") for(int d_=0;d_<2;++d_) _Pragma("unroll") for(int r=0;r<16;++r)o[d_][r]*=wsf[crow(r,hi)]; } }while(0)
  f32x16 pA0,pA1,pB0,pB1;
  int sl_prev=0,sl_cur=0,sl_next=SLOTB;
  #define ROT() do{sl_prev=sl_cur;sl_cur=sl_next;sl_next=(sl_next==(NSLOT-1)*SLOTB)?0:sl_next+SLOTB;}while(0)
  DMA_K(2,2*SLOTB);
  WAIT_BAR(3);
  NEGM(0); qkt(pA0,pA1,Kbase,qr,negm,r32,hi);asm volatile("s_nop 15\n\ts_nop 7":"+v"(pA0),"+v"(pA1));CMASK(pA0,pA1,0);
  START(pA0,pA1);
  _Pragma("unroll") for(int r=0;r<16;++r)pA1[r]=__builtin_amdgcn_exp2f(pA1[r]);
  WAIT_BAR(0);
  DMA_K(3,0);DMA_V(1,SLOTB);
  ROT();
  kload8(kf,kp0+sl_cur);
  WAIT_BAR(2);
  s16x4 vlo[8],vhi[8]; u32x4 pw0,pw1,pw2,pw3;
  #define PKW(P,B) cvtpk_s(P[B],P[B+1])
  #define PAF(k) __builtin_bit_cast(bf16x8,pw##k)
  #define VFR(i) (bf16x8){vlo[i][0],vlo[i][1],vlo[i][2],vlo[i][3],vhi[i][0],vhi[i][1],vhi[i][2],vhi[i][3]}
  #define PIN(x) asm volatile("":"+v"(x))
  #define MX3(a,b,c) __builtin_fmaxf(__builtin_fmaxf((a),(b)),(c))
  #define GAPA(MF,A0,A1,A2,A3,W0,W1,PW) do{ MF; sacc+=A0; sacc+=A1; sacc+=A2; sacc+=A3; PIN(sacc); W0; W1; PIN(PW); SBAR(); }while(0)
  #define EX(v) __builtin_amdgcn_exp2f(v)
  #define GAPB(MF,X,B) do{ MF; X[B]=EX(X[B]); X[B+1]=EX(X[B+1]); X[B+2]=EX(X[B+2]); X[B+3]=EX(X[B+3]); PIN(X); SBAR(); }while(0)
  #define VRD(i) do{ vlo[i]=vtr(vp_+(((i)>>2)*4096+((i)&3)*1024)); vhi[i]=vtr(vp_+(((i)>>2)*4096+((i)&3)*1024+512)); }while(0)
  #define KRD(G,j) do{ if(G){ kload2(kf,kp0+sl_next,j); SBAR(); } }while(0)
  #define STEP(C0,C1,P0,P1,t,GK,GV,GL) do{ NEGM(t); SBAR(); \
    const lds_cptr vp_=vp0+sl_prev; \
    VRD(0); SBAR(); float sacc=(P0[0]+P0[1]); \
    GAPA(C0=__builtin_amdgcn_mfma_f32_32x32x16_bf16(kf[0],qr[0],negm,0,0,0), P0[2],P0[3],P0[4],P0[5],     pw0[0]=PKW(P0,0), pw0[1]=PKW(P0,2), pw0); \
    VRD(4); SBAR(); GAPA(C1=__builtin_amdgcn_mfma_f32_32x32x16_bf16(kf[1],qr[0],negm,0,0,0), P0[6],P0[7],P0[8],P0[9],     pw0[2]=PKW(P0,4), pw0[3]=PKW(P0,6), pw0); \
    VRD(1); SBAR(); GAPA(C0=__builtin_amdgcn_mfma_f32_32x32x16_bf16(kf[2],qr[1],C0,0,0,0),   P0[10],P0[11],P0[12],P0[13], pw1[0]=PKW(P0,8), pw1[1]=PKW(P0,10), pw1); \
    VRD(5); SBAR(); GAPA(C1=__builtin_amdgcn_mfma_f32_32x32x16_bf16(kf[3],qr[1],C1,0,0,0),   P0[14],P0[15],P1[0],P1[1],   pw1[2]=PKW(P0,12),pw1[3]=PKW(P0,14), pw1); \
    VRD(2); SBAR(); GAPA(C0=__builtin_amdgcn_mfma_f32_32x32x16_bf16(kf[4],qr[2],C0,0,0,0),   P1[2],P1[3],P1[4],P1[5],     pw2[0]=PKW(P1,0), pw2[1]=PKW(P1,2), pw2); \
    VRD(6); SBAR(); GAPA(C1=__builtin_amdgcn_mfma_f32_32x32x16_bf16(kf[5],qr[2],C1,0,0,0),   P1[6],P1[7],P1[8],P1[9],     pw2[2]=PKW(P1,4), pw2[3]=PKW(P1,6), pw2); \
    VRD(3); SBAR(); GAPA(C0=__builtin_amdgcn_mfma_f32_32x32x16_bf16(kf[6],qr[3],C0,0,0,0),   P1[10],P1[11],P1[12],P1[13], pw3[0]=PKW(P1,8), pw3[1]=PKW(P1,10), pw3); \
    VRD(7); SBAR(); GAPA(C1=__builtin_amdgcn_mfma_f32_32x32x16_bf16(kf[7],qr[3],C1,0,0,0),   P1[14],P1[15],0.f,0.f,       pw3[2]=PKW(P1,12),pw3[3]=PKW(P1,14), pw3); \
    l_reg+=sacc; \
    if(GK){DMA_K((t)+3,sl_cur);} if(GV){DMA_V((t)+1,sl_next);} \
    CMASK(C0,C1,t); \
    { float a=MX3(C0[0],C0[1],C1[0]),b=MX3(C0[2],C0[3],C1[1]); a=MX3(a,C1[2],C1[3]); \
      _Pragma("unroll") for(int r=4;r<16;r+=4){a=MX3(a,C0[r],C0[r+1]);b=MX3(b,C0[r+2],C0[r+3]);a=MX3(a,C1[r],C1[r+1]);b=MX3(b,C1[r+2],C1[r+3]);} \
      float rm=__builtin_fmaxf(a,b); { auto rr=__builtin_amdgcn_permlane32_swap(__float_as_uint(rm),__float_as_uint(rm),false,false); rm=__builtin_fmaxf(__uint_as_float(rr[0]),__uint_as_float(rr[1])); } \
      resc=false; \
      if(__builtin_expect(__any(rm>(float)THRL),0)){ const float dl=__builtin_fmaxf(rm,0.f); mhat+=dl; \
        _Pragma("unroll") for(int r=0;r<16;++r){C0[r]-=dl;C1[r]-=dl;} \
        const float f=__builtin_amdgcn_exp2f(-dl); l_reg*=f; if(hi==0)wsf[r32]=f; resc=true; } } \
    SBAR(); \
    GAPB(o[0]=__builtin_amdgcn_mfma_f32_32x32x16_bf16(PAF(0),VFR(0),o[0],0,0,0), C0,0); \
    GAPB(o[1]=__builtin_amdgcn_mfma_f32_32x32x16_bf16(PAF(0),VFR(4),o[1],0,0,0), C0,4); \
    KRD(GL,0); GAPB(o[0]=__builtin_amdgcn_mfma_f32_32x32x16_bf16(PAF(1),VFR(1),o[0],0,0,0), C0,8); \
    KRD(GL,1); GAPB(o[1]=__builtin_amdgcn_mfma_f32_32x32x16_bf16(PAF(1),VFR(5),o[1],0,0,0), C0,12); \
    KRD(GL,2); GAPB(o[0]=__builtin_amdgcn_mfma_f32_32x32x16_bf16(PAF(2),VFR(2),o[0],0,0,0), C1,0); \
    KRD(GL,3); GAPB(o[1]=__builtin_amdgcn_mfma_f32_32x32x16_bf16(PAF(2),VFR(6),o[1],0,0,0), C1,4); \
    GAPB(o[0]=__builtin_amdgcn_mfma_f32_32x32x16_bf16(PAF(3),VFR(3),o[0],0,0,0), C1,8); \
    GAPB(o[1]=__builtin_amdgcn_mfma_f32_32x32x16_bf16(PAF(3),VFR(7),o[1],0,0,0), C1,12); \
    }while(0)
  int t=1;
  #undef CMASK
  #define CMASK(P0,P1,t) do{}while(0)
  for(;t+7<NT;t+=2){
    STEP(pB0,pB1,pA0,pA1,t,true,true,true);     WAIT_BAR(2); RESC(); ROT();
    STEP(pA0,pA1,pB0,pB1,t+1,true,true,true);   WAIT_BAR(2); RESC(); ROT();
  }
  #undef CMASK
  #define CMASK(P0,P1,t) do{ if((t)>=NT-6)nmask(P0,P1,64*(t),qabs,hi,tab); }while(0)
  #define ENDW(tt) do{ if((tt)+3<NT){WAIT_BAR(2);} else if((tt)+2<NT){WAIT_BAR(1);} else {WAIT_BAR(0);} }while(0)
  for(;t+1<NT;t+=2){
    STEP(pB0,pB1,pA0,pA1,t,(t+3<NT),(t+1<NT),(t+1<NT));       ENDW(t);   RESC(); ROT();
    STEP(pA0,pA1,pB0,pB1,t+1,(t+4<NT),(t+2<NT),(t+2<NT));     ENDW(t+1); RESC(); ROT();
  }
  STEP(pB0,pB1,pA0,pA1,NT-1,false,false,false); RESC();
  { float sacc=pB0[0]+pB0[1]; _Pragma("unroll") for(int r=2;r<16;++r)sacc+=pB0[r]; _Pragma("unroll") for(int r=0;r<16;++r)sacc+=pB1[r]; l_reg+=sacc;
    pw0=(u32x4){PKW(pB0,0),PKW(pB0,2),PKW(pB0,4),PKW(pB0,6)};pw1=(u32x4){PKW(pB0,8),PKW(pB0,10),PKW(pB0,12),PKW(pB0,14)};pw2=(u32x4){PKW(pB1,0),PKW(pB1,2),PKW(pB1,4),PKW(pB1,6)};pw3=(u32x4){PKW(pB1,8),PKW(pB1,10),PKW(pB1,12),PKW(pB1,14)};
    SBAR(); pv(o,vb0+sl_cur,PAF(0),PAF(1),PAF(2),PAF(3)); }
  #undef PKW
  #undef PAF
  #undef VFR
  #undef PIN
  #undef MX3
  #undef GAPA
  #undef GAPB
  #undef EX
  #undef VRD
  #undef KRD
  #undef STEP
  #undef ENDW
  {auto rr=__builtin_amdgcn_permlane32_swap(__float_as_uint(l_reg),__float_as_uint(l_reg),false,false);l_reg=__uint_as_float(rr[0])+__uint_as_float(rr[1]);}
  if(hi==0)wsf[32+r32]=l_reg;asm volatile("s_waitcnt lgkmcnt(0)":::"memory");
  float rli[16];
  #pragma unroll
  for(int r=0;r<16;++r)rli[r]=__builtin_amdgcn_rcpf(wsf[32+crow(r,hi)]);
  bf16*Ow=O+(rowbase+q0+wid*QBLK)*OP+h*D;
  { bf16*stg=(bf16*)(shm+LDS_OST)+wid*2048;
    #pragma unroll
    for(int r=0;r<16;++r){const int orow=crow(r,hi);
      #pragma unroll
      for(int d0=0;d0<2;++d0)stg[orow*64+d0*32+r32]=__float2bfloat16(o[d0][r]*rli[r]);}
    asm volatile("s_waitcnt lgkmcnt(0)":::"memory");
    #pragma unroll
    for(int i=0;i<4;++i){const int row=i*8+(lane>>3),ch=lane&7; const u32x4 v=*(const u32x4*)(stg+row*64+ch*8); ATTN_STORE16(Ow+(long)row*OP+ch*8,v);} }
  asm volatile("s_waitcnt lgkmcnt(0)\n\ts_barrier":::"memory");
  #undef DMA_K
  #undef DMA_V
  #undef CMASK
  #undef NEGM
  #undef START
  #undef RESC
  #undef ROT
}
constexpr int ATTN_LDS_BYTES=LDS_BYTES;
#undef SBAR
#undef WAIT_BAR
}
constexpr int ML_KM = 84992, ML_BIAS = 87040, ML_END = ML_BIAS + 4 * attn_body::NB_N * 4;
static_assert(attn_body::ATTN_LDS_BYTES <= ML_KM && ML_END <= RING_BYTES, "MoBA LDS map");
__device__ __forceinline__ void moba_task(Frame& F, const Ptrs& P, int task) {
    const int b = task >> 3, h = task & 7;
    LAS unsigned char* L = F.lds + RING_OFF;
    const int w = F.wave, lane = F.lane, tid = F.tid;
    LAS float* KMl = (LAS float*)(L + ML_KM); LAS float* BIASl = (LAS float*)(L + ML_BIAS);
    { const bf16* Kp = P.KM + ((size_t)b * SEQ + 256 * w) * 512 + h * 64; const int ch = lane & 7, rg = lane >> 3; float a[8];
#pragma unroll
      for (int e = 0; e < 8; ++e) a[e] = 0.f;
#pragma unroll 4
      for (int it = 0; it < 32; ++it) { const v4u v = *(const v4u*)(Kp + (size_t)(8 * it + rg) * 512 + ch * 8);
          a[0] += __uint_as_float(v.x << 16); a[1] += __uint_as_float(v.x & 0xffff0000u); a[2] += __uint_as_float(v.y << 16); a[3] += __uint_as_float(v.y & 0xffff0000u);
          a[4] += __uint_as_float(v.z << 16); a[5] += __uint_as_float(v.z & 0xffff0000u); a[6] += __uint_as_float(v.w << 16); a[7] += __uint_as_float(v.w & 0xffff0000u); }
#pragma unroll
      for (int e = 0; e < 8; ++e) { a[e] += __shfl_xor(a[e], 8); a[e] += __shfl_xor(a[e], 16); a[e] += __shfl_xor(a[e], 32); }
      if (lane < 8) {
#pragma unroll
          for (int e = 0; e < 8; ++e) KMl[w * 64 + ch * 8 + e] = a[e] * (1.f / 256.f); } }
    for (int i = tid; i < 4 * attn_body::NB_N; i += 512) { const int sft = i / attn_body::NB_N, d = (i % attn_body::NB_N) + sft - attn_body::NB_OFF; float v;
        if (d < 0) v = -INFINITY; else { int bk; if (d < 16) bk = d; else { bk = 16 + (int)(__logf((float)(d > 2048 ? 2048 : d) * (1.f / 16.f)) / 2.0794415416798357f * 16.f); bk = bk > 31 ? 31 : bk; }
            v = P.rel_bias[bk * 8 + h] * LOG2E; }
        BIASl[i] = v; }
    __syncthreads();
    const float b31 = __builtin_bit_cast(float, __builtin_amdgcn_readfirstlane(__builtin_bit_cast(int, BIASl[attn_body::NB_OFF + 128])));
    for (int qi = 0; qi < 8; ++qi) {
        const int qb = (qi & 1) ? (qi >> 1) : 7 - (qi >> 1);
        int tl = tid; asm volatile("" : "+v"(tl));
        attn_body::attn_unit<8>(tl, b, h, qb, (const attn_body::bf16*)P.QM, (const attn_body::bf16*)P.KM, (const attn_body::bf16*)P.VM, (attn_body::bf16*)(P.MIX + 512), (char*)L,
                                (attn_body::lds_cfptr)KMl, (attn_body::lds_cfptr)BIASl, b31);
    }
    __syncthreads();
}

#ifndef REPMASK
#define REPMASK 0
#endif
#define NREP(k) ((((REPMASK) >> (k)) & 1) + 1)
struct Args { const float* in[15]; float* out; unsigned char* ws; int ph_lo, ph_hi; };
__global__ void __launch_bounds__(NWAVES * 64, 2) hybrid_fwd(Args args) {
    extern __shared__ __attribute__((aligned(16))) unsigned char lds[];
    Frame F;
    F.lds = (LAS unsigned char*)lds;
    F.MISC = (volatile LAS unsigned*)(F.lds + MISC_OFF);
    F.tid = threadIdx.x; F.lane = F.tid & 63; F.wave = __builtin_amdgcn_readfirstlane(F.tid >> 6);
    F.G = gridDim.x; { const int bx = blockIdx.x; F.vcu = (F.G % 8 == 0) ? (bx % 8) * (F.G / 8) + bx / 8 : bx; }
    unsigned char* ws = args.ws;
    F.ctl = (gu32*)(ws + WS_CTL);
    Ptrs P;
    P.x = args.in[0]; P.c = args.in[1]; P.w_ada = args.in[2]; P.b_ada = args.in[3]; P.g_mix = args.in[4]; P.w_in = args.in[5]; P.w_gate = args.in[6]; P.b_gate = args.in[7];
    P.g_gla = args.in[8]; P.rel_bias = args.in[9]; P.w_out = args.in[10]; P.g_mlp = args.in[11]; P.w_ff1 = args.in[12]; P.w_ff2 = args.in[13]; P.g_final = args.in[14];
    P.out = args.out; P.ada = (float*)(ws + WS_ADA); P.loga = (float*)(ws + WS_LOGA);
    P.Win_t = (bf16*)(ws + WS_WIN); P.Wout_t = (bf16*)(ws + WS_WOUT); P.W1_t = (bf16*)(ws + WS_W1); P.W2_t = (bf16*)(ws + WS_W2);
    P.XN = (bf16*)(ws + WS_XN); P.G4 = (bf16*)(ws + WS_G4); P.QM = (bf16*)(ws + WS_QM); P.KM = (bf16*)(ws + WS_KM); P.VM = (bf16*)(ws + WS_VM); P.U = (bf16*)(ws + WS_U); P.MIX = (bf16*)(ws + WS_MIX);
    for (int u = F.tid; u < (LDS_BYTES - LDSCTL_OFF) / 4; u += NWAVES * 64) ((LAS unsigned*)(F.lds + LDSCTL_OFF))[u] = 0u;
    __syncthreads();
    XcdBarrier bar; bar.bar = (unsigned*)(F.ctl + CW_BAR); bar.x = 0; bar.st = nullptr;
    if (N_LAUNCHES == 1) bar = xcd_barrier_post((unsigned*)(F.ctl + CW_BAR), F.MISC + 8);
#define GRID_BAR(seam) do { if (N_LAUNCHES != 1) { if (F.tid == 0) __hip_atomic_store(F.ctl + CW_TMO, 0xBADBA0u | (unsigned)(seam), RLX_AGENT); } else { xcd_barrier(bar); } } while (0)
    const int lo = args.ph_lo, hi = args.ph_hi;
#define IN(k) (lo <= (k) && (k) < hi)
#define BOTH(k) (IN(k) && IN((k) + 1))

    if (IN(0)) { for (int rep = 0; rep < NREP(0); ++rep) { p0_prologue(F, P); if (rep + 1 < NREP(0)) __syncthreads(); } if (BOTH(0)) GRID_BAR(0); }
    if (IN(1)) { for (int rep = 0; rep < NREP(1); ++rep) norm_phase<0>(F, P.x, P.XN, nullptr, P.g_mix, P.ada, 0, D); if (BOTH(1)) GRID_BAR(1); }
    if (IN(2)) {
        pg8::Gemm g{P.XN, P.Win_t, M, NPROJ, D}; pg8::StaticOrder S; S.init(M, NPROJ, F.G, (int)blockIdx.x);
        pg8::EpiProj E{P.G4, P.QM, P.KM, P.VM, P.loga, P.b_gate};
        for (int rep = 0; rep < NREP(2); ++rep) pg8::gemm_phase<pg8::EpiProj, pg8::StaticOrder, true, true>(F.lds + RING_OFF, g, S, E);
        if (BOTH(2)) GRID_BAR(2);
    }
    if (IN(3)) {
        for (int rep = 0; rep < NREP(3); ++rep) {
        for (int rep2 = 0; rep2 < NREP(9); ++rep2) for (int t = blockIdx.x; t < BATCH * 4; t += F.G) gla_task(F, P, t);
        for (int rep2 = 0; rep2 < NREP(10); ++rep2) for (int t = blockIdx.x; t < BATCH * 8; t += F.G) moba_task(F, P, t);
        }
        if (BOTH(3)) GRID_BAR(3);
    }
    if (IN(4)) {
        pg8::Gemm g{P.MIX, P.Wout_t, M, D, D}; pg8::StaticOrder S; S.init(M, D, F.G, (int)blockIdx.x);
        pg8::EpiRes E{P.x, P.out, P.ada + 2 * D, SEQ, ADA_LD};
        for (int rep = 0; rep < NREP(4); ++rep) pg8::gemm_phase<pg8::EpiRes, pg8::StaticOrder, true, true>(F.lds + RING_OFF, g, S, E);
        if (BOTH(4)) GRID_BAR(4);
    }
    if (IN(5)) { for (int rep = 0; rep < NREP(5); ++rep) norm_phase<0>(F, P.out, P.XN, nullptr, P.g_mlp, P.ada, 3 * D, 4 * D); if (BOTH(5)) GRID_BAR(5); }
    if (IN(6)) {
        pg8::Gemm g{P.XN, P.W1_t, M, FF, D}; pg8::StaticOrder S; S.init(M, FF, F.G, (int)blockIdx.x);
        pg8::EpiRelu2 E{P.U, FF};
        for (int rep = 0; rep < NREP(6); ++rep) pg8::gemm_phase<pg8::EpiRelu2, pg8::StaticOrder, true, true>(F.lds + RING_OFF, g, S, E);
        if (BOTH(6)) GRID_BAR(6);
    }
    if (IN(7)) {
        pg8::Gemm g{P.U, P.W2_t, M, D, FF}; pg8::StaticOrder S; S.init(M, D, F.G, (int)blockIdx.x);
        if (NREP(7) > 1) { pg8::EpiRes E0{P.out, (float*)(ws + WS_MIX), P.ada + 5 * D, SEQ, ADA_LD}; pg8::gemm_phase<pg8::EpiRes, pg8::StaticOrder, true, true>(F.lds + RING_OFF, g, S, E0); }
        pg8::EpiRes E{P.out, P.out, P.ada + 5 * D, SEQ, ADA_LD};
        pg8::gemm_phase<pg8::EpiRes, pg8::StaticOrder, true, true>(F.lds + RING_OFF, g, S, E);
        if (BOTH(7)) GRID_BAR(7);
    }
    if (IN(8)) { if (NREP(8) > 1) norm_phase<1>(F, P.out, nullptr, (float*)(ws + WS_MIX), P.g_final, nullptr, 0, 0);
        norm_phase<1>(F, P.out, nullptr, P.out, P.g_final, nullptr, 0, 0); }
#undef IN
#undef BOTH
}

extern "C" void kernel_launch(void* const* d_in, const int* in_sizes, int n_in, void* d_out, int out_size, void* d_ws, size_t ws_size, hipStream_t stream) {
    static int grid = 0;
    if (grid == 0) {
        if (n_in != 15 || in_sizes[0] != M * D || out_size != M * D || ws_size < WS_END) { fprintf(stderr, "kernel_launch: unexpected shapes (n_in %d, in0 %d, out %d, ws %zu); nothing launched\n", n_in, n_in > 0 ? in_sizes[0] : -1, out_size, ws_size); grid = -1; return; }
        int dev = 0, cus = 0, per_cu = 0;
        if (hipGetDevice(&dev) != hipSuccess || hipDeviceGetAttribute(&cus, hipDeviceAttributeMultiprocessorCount, dev) != hipSuccess) { fprintf(stderr, "kernel_launch: device query failed\n"); grid = -1; return; }
        if (hipFuncSetAttribute((const void*)hybrid_fwd, hipFuncAttributeMaxDynamicSharedMemorySize, LDS_BYTES) != hipSuccess) { fprintf(stderr, "kernel_launch: hipFuncSetAttribute failed\n"); grid = -1; return; }
        if (hipOccupancyMaxActiveBlocksPerMultiprocessor(&per_cu, (const void*)hybrid_fwd, NWAVES * 64, LDS_BYTES) != hipSuccess || per_cu < 1)
            fprintf(stderr, "kernel_launch: note: occupancy query reports %d workgroups per CU\n", per_cu);
        (void)hipGetLastError();
        grid = cus;
    }
    if (grid < 0) return;
    if (hipMemsetAsync((char*)d_ws + WS_CTL, 0, CTL_ZERO_BYTES, stream) != hipSuccess) { fprintf(stderr, "kernel_launch: memset failed\n"); return; }
    Args a{};
    for (int i = 0; i < 15; ++i) a.in[i] = (const float*)d_in[i];
    a.out = (float*)d_out; a.ws = (unsigned char*)d_ws;
    for (int li = 0; li < N_LAUNCHES; ++li) {
        a.ph_lo = (N_LAUNCHES == 1) ? 0 : li; a.ph_hi = (N_LAUNCHES == 1) ? N_PHASES : li + 1;
        hipLaunchKernelGGL(hybrid_fwd, dim3(grid), dim3(NWAVES * 64), LDS_BYTES, stream, a);
        const hipError_t le = hipPeekAtLastError();
        if (le != hipSuccess) { fprintf(stderr, "kernel_launch: launch %d failed: %s\n", li, hipGetErrorName(le)); break; }
    }
}
```
